# Optimizing an MI355X kernel written in HIP

```python
import jax, jax.numpy as jnp
from jax import lax
import numpy as np

D_MODEL = 1024
BATCH = 2
SEQ = 8192
DEPTH = 4

GRID_W = 64
CTX_LEN = 256
N_BRANCH = 3
BRANCH_W = 512
ML_HEADS = 8
ML_DH = 64
ML_W = ML_HEADS * ML_DH
ML_QK_W = 2 * ML_W
CONV_K = 5
MLA_HEADS = 8
Q_LORA = 384
KV_LORA = 256
NOPE_D = 64
ROPE_D = 32
QK_D = NOPE_D + ROPE_D
MLA_DV = 64
RET_HEADS = 8
RET_DK = 32
RET_DV = 64
RET_W = RET_HEADS * RET_DV
N_EXPERTS = 16
EXPERT_FF = 1024
CAP_FACTOR = 2
CHUNK = 128
QBLK = 128
ROPE_BASE = 10000.0
EPS = 1e-6
PROJ_WIDTHS = (ML_QK_W, ML_W, ML_W, 4 * ML_HEADS, Q_LORA, KV_LORA, ROPE_D,
               RET_HEADS * RET_DK, RET_HEADS * RET_DK, RET_W, RET_W, N_BRANCH * D_MODEL)
N_IN = sum(PROJ_WIDTHS)

kernel_name = 'hybrid_mlstm_mla_retention_ecmoe_dit'


def _rmsnorm(x, w):
    xf = x.astype(jnp.float32)
    out = xf * lax.rsqrt(jnp.mean(xf * xf, axis=-1, keepdims=True) + EPS)
    return (out * w.astype(jnp.float32)).astype(x.dtype)


def _head_layernorm(y, w):
    yf = y.astype(jnp.float32)
    mu = jnp.mean(yf, axis=-1, keepdims=True)
    var = jnp.mean(jnp.square(yf - mu), axis=-1, keepdims=True)
    out = (yf - mu) * lax.rsqrt(var + EPS)
    b, l = y.shape[:2]
    return (out.reshape(b, l, -1) * w.astype(jnp.float32)).astype(w.dtype)


def _ada(cond, w, b):
    m = jax.nn.silu(cond) @ w + b
    return jnp.split(m[..., None, :], 6, axis=-1)


def _split_proj(p):
    idx = np.cumsum(PROJ_WIDTHS)[:-1].tolist()
    return jnp.split(p, idx, axis=-1)


def _rope_tables(row, col, dim):
    half = dim // 4
    inv = ROPE_BASE ** (-jnp.arange(half, dtype=jnp.float32) / half)
    ar = row[:, None] * inv
    ac = col[:, None] * inv
    return (jnp.cos(ar), jnp.sin(ar), jnp.cos(ac), jnp.sin(ac))


def _rot(x, cos, sin):
    xf = x.astype(jnp.float32)
    x1, x2 = jnp.split(xf, 2, axis=-1)
    c = cos[None, :, None, :]
    s = sin[None, :, None, :]
    return jnp.concatenate([x1 * c - x2 * s, x1 * s + x2 * c], axis=-1).astype(x.dtype)


def _rope2d(x, tabs):
    cr, sr, cc, sc = tabs
    d2 = x.shape[-1] // 2
    return jnp.concatenate([_rot(x[..., :d2], cr, sr), _rot(x[..., d2:], cc, sc)], axis=-1)


def _dwconv(x, w, b):
    k = w.shape[0]
    out = lax.conv_general_dilated(x, w[:, None, :].astype(x.dtype), window_strides=(1,),
                                   padding=[(k // 2, k // 2)],
                                   dimension_numbers=('NWC', 'WIO', 'NWC'),
                                   feature_group_count=x.shape[-1])
    return out + b


def _to_chunks(t):
    b, h, l = t.shape[:3]
    t = t.reshape((b, h, l // CHUNK, CHUNK) + t.shape[3:])
    return jnp.moveaxis(t, 2, 0)


def _from_chunks(t):
    t = jnp.moveaxis(t, 0, 2)
    b, h, nc, ch = t.shape[:4]
    return t.reshape((b, h, nc * ch) + t.shape[4:])


def _mlstm_scan(args, state):
    q, k, v, ig, lf = args
    idx = jnp.arange(CHUNK)
    causal = idx[:, None] >= idx[None, :]

    def step(carry, inp):
        C, n, m = carry
        qc, kc, vc, igc, lfc = inp
        b = jnp.cumsum(lfc, axis=-1)
        a = b + m[..., None]
        dlog = jnp.where(causal, b[..., :, None] - b[..., None, :] + igc[..., None, :], -jnp.inf)
        mt = jnp.maximum(a, jnp.max(dlog, axis=-1))
        w = jnp.exp(dlog - mt[..., None])
        inter = jnp.exp(a - mt)
        s = jnp.einsum('bhtd,bhsd->bhts', qc, kc) * w
        num = jnp.einsum('bhts,bhsv->bhtv', s, vc) + inter[..., None] * jnp.einsum('bhvd,bhtd->bhtv', C, qc)
        den = jnp.sum(s, axis=-1) + inter * jnp.einsum('bhd,bhtd->bht', n, qc)
        h = num / jnp.maximum(jnp.abs(den), jnp.exp(-mt))[..., None]
        bl = b[..., -1]
        g = bl[..., None] - b + igc
        m_new = jnp.maximum(bl + m, jnp.max(g, axis=-1))
        dp = jnp.exp(bl + m - m_new)
        wg = jnp.exp(g - m_new[..., None])
        C = dp[..., None, None] * C + jnp.einsum('bhs,bhsv,bhsd->bhvd', wg, vc, kc)
        n = dp[..., None] * n + jnp.einsum('bhs,bhsd->bhd', wg, kc)
        return (C, n, m_new), h

    state, hs = lax.scan(step, state, tuple(_to_chunks(t) for t in (q, k, v, ig, lf)))
    return _from_chunks(hs), state


def _retention_scan(args, lg, R):
    q, k, v = args
    idx = jnp.arange(CHUNK, dtype=jnp.float32)
    diff = idx[:, None] - idx[None, :]
    dmat = jnp.exp(jnp.where(diff[None] >= 0, diff[None] * lg[:, None, None], -jnp.inf))
    xi = jnp.exp((idx + 1.0)[None] * lg[:, None])
    kd = jnp.exp((CHUNK - 1.0 - idx)[None] * lg[:, None])
    cd = jnp.exp(CHUNK * lg)

    def step(R, inp):
        qc, kc, vc = inp
        s = jnp.einsum('bhtd,bhsd->bhts', qc, kc) * dmat
        o = jnp.einsum('bhts,bhsv->bhtv', s, vc) + xi[..., None] * jnp.einsum('bhtd,bhdv->bhtv', qc, R)
        R = cd[:, None, None] * R + jnp.einsum('bhsd,hs,bhsv->bhdv', kc, kd, vc)
        return R, o

    R, os_ = lax.scan(step, R, tuple(_to_chunks(t) for t in (q, k, v)))
    return _from_chunks(os_), R


def _bidirectional(scan_f, scan_b, ctx_f, lat_f, ctx_b, lat_b, init):
    flip = lambda ts: tuple(jnp.flip(t, axis=2) for t in ts)
    hc_f, st_f = scan_f(ctx_f, init)
    hl_f, _ = scan_f(lat_f, st_f)
    hc_b, st_b = scan_b(flip(ctx_b), init)
    hl_b, _ = scan_b(flip(lat_b), st_b)
    return hl_f + jnp.flip(hl_b, axis=2), hc_f + jnp.flip(hc_b, axis=2)


def _mlstm_inputs(qk_pre, v_pre, gates, conv_w, conv_b):
    b, l, _ = qk_pre.shape
    qk = jax.nn.silu(_dwconv(qk_pre, conv_w, conv_b))
    q, k = jnp.split(qk, 2, axis=-1)
    heads = lambda t: t.reshape(b, l, ML_HEADS, ML_DH).transpose(0, 2, 1, 3).astype(jnp.float32)
    q, k, v = heads(q), heads(k) * (ML_DH ** -0.5), heads(v_pre)
    g = gates.astype(jnp.float32).reshape(b, l, 4, ML_HEADS).transpose(2, 0, 3, 1)
    fwd = (q, k, v, g[0], jax.nn.log_sigmoid(g[1]))
    bwd = (q, k, v, g[2], jax.nn.log_sigmoid(g[3]))
    return fwd, bwd


def _mla_q(q_lat, qa_norm, wq_b, qn_w, tabs):
    b, l, _ = q_lat.shape
    q = (_rmsnorm(q_lat, qa_norm) @ wq_b).reshape(b, l, MLA_HEADS, QK_D)
    q = _rmsnorm(q, qn_w)
    if tabs is not None:
        q = jnp.concatenate([q[..., :NOPE_D], _rope2d(q[..., NOPE_D:], tabs)], axis=-1)
    return q


def _mla_kv(kv_lat, k_rope, kva_norm, wkv_b, kn_w, tabs):
    b, l, _ = kv_lat.shape
    kv = (_rmsnorm(kv_lat, kva_norm) @ wkv_b).reshape(b, l, MLA_HEADS, NOPE_D + MLA_DV)
    k_nope, v = kv[..., :NOPE_D], kv[..., NOPE_D:]
    k_r = jnp.broadcast_to(k_rope[:, :, None, :], (b, l, MLA_HEADS, ROPE_D))
    k = _rmsnorm(jnp.concatenate([k_nope, k_r], axis=-1), kn_w)
    if tabs is not None:
        k = jnp.concatenate([k[..., :NOPE_D], _rope2d(k[..., NOPE_D:], tabs)], axis=-1)
    return k, v


def _attend(q, k, v):
    b, s, h, dq = q.shape
    nb = s // QBLK
    qb = jnp.moveaxis(q.reshape(b, nb, QBLK, h, dq), 1, 0)
    scale = dq ** -0.5

    def one(qi):
        sc = jnp.einsum('bqhd,bkhd->bhqk', qi, k).astype(jnp.float32) * scale
        p = jax.nn.softmax(sc, axis=-1)
        return jnp.einsum('bhqk,bkhd->bqhd', p.astype(v.dtype), v)

    o = lax.map(one, qb)
    return jnp.moveaxis(o, 0, 1).reshape(b, s, h * v.shape[-1])


def _ret_inputs(q, k, v, tabs):
    b, l, _ = q.shape
    q = q.reshape(b, l, RET_HEADS, RET_DK)
    k = k.reshape(b, l, RET_HEADS, RET_DK)
    if tabs is not None:
        q, k = _rope2d(q, tabs), _rope2d(k, tabs)
    t = lambda a: a.transpose(0, 2, 1, 3).astype(jnp.float32)
    return (t(q), t(k) * (RET_DK ** -0.5), t(v.reshape(b, l, RET_HEADS, RET_DV)))


def _ret_log_gammas():
    lg = jnp.log1p(-jnp.exp2(-5.0 - jnp.arange(RET_HEADS, dtype=jnp.float32)))
    return lg, lg[::-1]


def _merge(ys, logits, w_branch, w_out):
    b, l, _ = logits.shape
    y = jnp.stack(ys, axis=2)
    br = jnp.einsum('blnc,ncd->blnd', y, w_branch)
    gate = jax.nn.sigmoid(logits.reshape(b, l, N_BRANCH, D_MODEL))
    return jnp.sum(gate * br, axis=2) @ w_out


def _mixer(hl, hc, tabs_mla, tabs_ret, need_ctx, w_in, b_in, conv_w, conv_b, ml_norm_w,
           qa_norm, wq_b, kva_norm, wkv_b, qn_w, kn_w, ret_norm_w, w_branch, w_out):
    pl = _split_proj(hl @ w_in + b_in)
    pc = _split_proj(hc @ w_in + b_in)
    bsz = hl.shape[0]
    lat_f, lat_b = _mlstm_inputs(pl[0], pl[1], pl[3], conv_w, conv_b)
    ctx_f, ctx_b = _mlstm_inputs(pc[0], pc[1], pc[3], conv_w, conv_b)
    init_m = (jnp.zeros((bsz, ML_HEADS, ML_DH, ML_DH), jnp.float32),
              jnp.zeros((bsz, ML_HEADS, ML_DH), jnp.float32),
              jnp.zeros((bsz, ML_HEADS), jnp.float32))
    al, ac = _bidirectional(_mlstm_scan, _mlstm_scan, ctx_f, lat_f, ctx_b, lat_b, init_m)
    ya_l = jax.nn.sigmoid(pl[2]) * _head_layernorm(al.transpose(0, 2, 1, 3), ml_norm_w)
    kc, vc = _mla_kv(pc[5], pc[6], kva_norm, wkv_b, kn_w, None)
    kl, vl = _mla_kv(pl[5], pl[6], kva_norm, wkv_b, kn_w, tabs_mla)
    ql = _mla_q(pl[4], qa_norm, wq_b, qn_w, tabs_mla)
    yb_l = _attend(ql, jnp.concatenate([kc, kl], axis=1), jnp.concatenate([vc, vl], axis=1))
    lg_f, lg_b = _ret_log_gammas()
    scan_f = lambda args, st: _retention_scan(args, lg_f, st)
    scan_b = lambda args, st: _retention_scan(args, lg_b, st)
    r_lat = _ret_inputs(pl[7], pl[8], pl[9], tabs_ret)
    r_ctx = _ret_inputs(pc[7], pc[8], pc[9], None)
    init_r = jnp.zeros((bsz, RET_HEADS, RET_DK, RET_DV), jnp.float32)
    rl, rc = _bidirectional(scan_f, scan_b, r_ctx, r_lat, r_ctx, r_lat, init_r)
    yc_l = jax.nn.silu(pl[10]) * _head_layernorm(rl.transpose(0, 2, 1, 3), ret_norm_w)
    y_lat = _merge((ya_l, yb_l, yc_l), pl[11], w_branch, w_out)
    if not need_ctx:
        return y_lat, None
    ya_c = jax.nn.sigmoid(pc[2]) * _head_layernorm(ac.transpose(0, 2, 1, 3), ml_norm_w)
    qc = _mla_q(pc[4], qa_norm, wq_b, qn_w, None)
    yb_c = _attend(qc, kc, vc)
    yc_c = jax.nn.silu(pc[10]) * _head_layernorm(rc.transpose(0, 2, 1, 3), ret_norm_w)
    y_ctx = _merge((ya_c, yb_c, yc_c), pc[11], w_branch, w_out)
    return y_lat, y_ctx


def _ec_moe(h, router_w, w1, w3, w2):
    bsz, n, _ = h.shape
    cap = CAP_FACTOR * n // N_EXPERTS
    aff = jax.nn.softmax((h @ router_w).astype(jnp.float32), axis=-1)
    g, idx = lax.top_k(jnp.swapaxes(aff, 1, 2), cap)
    bidx = jnp.arange(bsz)[:, None, None]
    xs = h[bidx, idx]
    hid = jax.nn.silu(jnp.einsum('becd,edf->becf', xs, w1)) * jnp.einsum('becd,edf->becf', xs, w3)
    ys = jnp.einsum('becf,efd->becd', hid, w2) * g[..., None].astype(h.dtype)
    return jnp.zeros_like(h).at[bidx, idx].add(ys.astype(h.dtype))


def setup_inputs(seed: int = 0) -> dict:
    key = jax.random.key(seed)
    ks = jax.random.split(key, 32)
    f32 = jnp.float32
    nrm = lambda k, shape: jax.random.normal(k, shape, f32)
    w = lambda k, shape, fan_in, s=1.0: nrm(k, shape) * (s * fan_in ** -0.5)
    gain = lambda k, shape: 1.0 + 0.02 * nrm(k, shape)
    bias = lambda k, shape: 0.02 * nrm(k, shape)
    D = D_MODEL
    b_in = bias(ks[9], (DEPTH, N_IN))
    goff = ML_QK_W + 2 * ML_W
    fb = jnp.linspace(3.0, 6.0, ML_HEADS, dtype=f32) + bias(ks[10], (DEPTH, 2, ML_HEADS))
    b_in = b_in.at[:, goff + ML_HEADS:goff + 2 * ML_HEADS].set(fb[:, 0])
    b_in = b_in.at[:, goff + 3 * ML_HEADS:goff + 4 * ML_HEADS].set(fb[:, 1])
    return {
        'x': nrm(ks[0], (BATCH, SEQ, D)),
        'c': nrm(ks[1], (BATCH, D)),
        'ctx': nrm(ks[2], (BATCH, CTX_LEN, D)),
        'c_ctx': nrm(ks[3], (D,)),
        'ada_w': w(ks[4], (DEPTH, D, 6 * D), D, 0.5),
        'ada_b': bias(ks[5], (DEPTH, 6 * D)),
        'norm1_w': gain(ks[6], (DEPTH, D)),
        'norm2_w': gain(ks[7], (DEPTH, D)),
        'w_in': w(ks[8], (DEPTH, D, N_IN), D),
        'b_in': b_in,
        'conv_w': w(ks[11], (DEPTH, CONV_K, ML_QK_W), CONV_K),
        'conv_b': bias(ks[12], (DEPTH, ML_QK_W)),
        'ml_norm_w': gain(ks[13], (DEPTH, ML_W)),
        'mla_qa_norm': gain(ks[14], (DEPTH, Q_LORA)),
        'mla_wq_b': w(ks[15], (DEPTH, Q_LORA, MLA_HEADS * QK_D), Q_LORA),
        'mla_kva_norm': gain(ks[16], (DEPTH, KV_LORA)),
        'mla_wkv_b': w(ks[17], (DEPTH, KV_LORA, MLA_HEADS * (NOPE_D + MLA_DV)), KV_LORA),
        'q_norm_w': gain(ks[18], (DEPTH, QK_D)),
        'k_norm_w': gain(ks[19], (DEPTH, QK_D)),
        'ret_norm_w': gain(ks[20], (DEPTH, RET_W)),
        'w_branch': w(ks[21], (DEPTH, N_BRANCH, BRANCH_W, D), BRANCH_W),
        'w_out': w(ks[22], (DEPTH, D, D), D),
        'router_w': w(ks[23], (DEPTH, D, N_EXPERTS), D),
        'exp_w1': w(ks[24], (DEPTH, N_EXPERTS, D, EXPERT_FF), D),
        'exp_w3': w(ks[25], (DEPTH, N_EXPERTS, D, EXPERT_FF), D),
        'exp_w2': w(ks[26], (DEPTH, N_EXPERTS, EXPERT_FF, D), EXPERT_FF),
    }


def reference(x, c, ctx, c_ctx, ada_w, ada_b, norm1_w, norm2_w, w_in, b_in, conv_w, conv_b,
              ml_norm_w, mla_qa_norm, mla_wq_b, mla_kva_norm, mla_wkv_b, q_norm_w, k_norm_w,
              ret_norm_w, w_branch, w_out, router_w, exp_w1, exp_w3, exp_w2):
    n_lat = x.shape[1]
    rows = n_lat // GRID_W
    row = jnp.repeat(jnp.arange(rows), GRID_W).astype(jnp.float32)
    col = jnp.tile(jnp.arange(GRID_W), rows).astype(jnp.float32)
    tabs_mla = _rope_tables(row, col, ROPE_D)
    tabs_ret = _rope_tables(row, col, RET_DK)
    for l in range(DEPTH):
        last = l == DEPTH - 1
        sh1, sc1, g1, sh2, sc2, g2 = _ada(c, ada_w[l], ada_b[l])
        csh1, csc1, cg1, csh2, csc2, cg2 = _ada(c_ctx, ada_w[l], ada_b[l])
        hl = _rmsnorm(x, norm1_w[l]) * (1.0 + sc1) + sh1
        hc = _rmsnorm(ctx, norm1_w[l]) * (1.0 + csc1) + csh1
        y_lat, y_ctx = _mixer(hl, hc, tabs_mla, tabs_ret, not last, w_in[l], b_in[l], conv_w[l], conv_b[l],
                              ml_norm_w[l], mla_qa_norm[l], mla_wq_b[l], mla_kva_norm[l], mla_wkv_b[l],
                              q_norm_w[l], k_norm_w[l], ret_norm_w[l], w_branch[l], w_out[l])
        x = x + g1 * y_lat
        hl = _rmsnorm(x, norm2_w[l]) * (1.0 + sc2) + sh2
        x = x + g2 * _ec_moe(hl, router_w[l], exp_w1[l], exp_w3[l], exp_w2[l])
        if not last:
            ctx = ctx + cg1 * y_ctx
            hc = _rmsnorm(ctx, norm2_w[l]) * (1.0 + csc2) + csh2
            ctx = ctx + cg2 * _ec_moe(hc, router_w[l], exp_w1[l], exp_w3[l], exp_w2[l])
    return x
```

```cpp
#include <hip/hip_runtime.h>
#include <stdint.h>
#include <stdio.h>

#define DEVI __device__ __forceinline__
typedef unsigned short u16;
typedef short bf16x8 __attribute__((ext_vector_type(8)));
typedef float f32x16 __attribute__((ext_vector_type(16)));
typedef float f32x4 __attribute__((ext_vector_type(4)));
typedef float f32x2 __attribute__((ext_vector_type(2)));
typedef unsigned u32x4 __attribute__((ext_vector_type(4)));
typedef unsigned u32x2 __attribute__((ext_vector_type(2)));

constexpr int DM = 1024, NB = 2, SEQ = 8192, CTXL = 256, DEPTH = 4;
constexpr int TL = NB * SEQ, TC = NB * CTXL, TT = TL + TC;
constexpr int NIN = 7360, NINP = 7424;
constexpr int O_QK = 0, O_V = 1024, O_OG = 1536, O_GATES = 2048, O_QLAT = 2080, O_KVLAT = 2464, O_KROPE = 2720,
              O_RQ = 2752, O_RK = 3008, O_RV = 3264, O_RG = 3776, O_LOG = 4288;
constexpr int NE = 16, FF = 1024, KEYS = CTXL + SEQ;
constexpr int ESLOTS = 2304;
constexpr int NCHUNK = 66;
constexpr float EPS = 1e-6f, LOG2E = 1.4426950408889634f;
constexpr int NTHR = 512;
constexpr int LDS_BYTES = 136 * 1024;

DEVI unsigned cvtpk(float lo, float hi) { unsigned r; asm("v_cvt_pk_bf16_f32 %0, %1, %2" : "=v"(r) : "v"(lo), "v"(hi)); return r; }
DEVI float bf2f(u16 v) { return __uint_as_float(((unsigned)v) << 16); }
DEVI float bflo(unsigned v) { return __uint_as_float(v << 16); }
DEVI float bfhi(unsigned v) { return __uint_as_float(v & 0xffff0000u); }
DEVI u16 f2bf(float f) { return (u16)(cvtpk(f, 0.f) & 0xffffu); }
DEVI int crow(int i, int h) { return (i & 3) + 8 * (i >> 2) + 4 * h; }
DEVI float sum32(float v) { const auto r = __builtin_amdgcn_permlane32_swap(__float_as_uint(v), __float_as_uint(v), false, false); return __uint_as_float(r[0]) + __uint_as_float(r[1]); }
DEVI float max32(float v) { const auto r = __builtin_amdgcn_permlane32_swap(__float_as_uint(v), __float_as_uint(v), false, false); return fmaxf(__uint_as_float(r[0]), __uint_as_float(r[1])); }
#define DPP_F(v, ctrl) __uint_as_float((unsigned)__builtin_amdgcn_mov_dpp((int)__float_as_uint(v), (ctrl), 0xf, 0xf, true))
DEVI float wave_sum(float v) {
  v += DPP_F(v, 0xB1);
  v += DPP_F(v, 0x4E);
  v += DPP_F(v, 0x141);
  v += DPP_F(v, 0x140);
  { const auto r = __builtin_amdgcn_permlane16_swap(__float_as_uint(v), __float_as_uint(v), false, false); v = __uint_as_float(r[0]) + __uint_as_float(r[1]); }
  return sum32(v);
}
DEVI float shfl_up_f(float v, int o, int lane) { return __uint_as_float((unsigned)__builtin_amdgcn_ds_bpermute((lane - o) << 2, (int)__float_as_uint(v))); }
DEVI unsigned shfl_up_u(unsigned v, int o, int lane) { return (unsigned)__builtin_amdgcn_ds_bpermute((lane - o) << 2, (int)v); }
DEVI float lane63(float v) { return __uint_as_float((unsigned)__builtin_amdgcn_readlane((int)__float_as_uint(v), 63)); }
DEVI float sigmoidf_(float x) { return __builtin_amdgcn_rcpf(1.f + __expf(-x)); }
DEVI float siluf_(float x) { return x * __builtin_amdgcn_rcpf(1.f + __expf(-x)); }
DEVI f32x16 mfma(bf16x8 a, bf16x8 b, f32x16 c) { return __builtin_amdgcn_mfma_f32_32x32x16_bf16(a, b, c, 0, 0, 0); }
DEVI bf16x8 ld_frag(const u16* p) { return *reinterpret_cast<const bf16x8*>(p); }
DEVI float sumsq8_(u32x4 t) { float s_ = 0.f;
#pragma unroll
  for (int j = 0; j < 4; ++j) { const float a = bflo(t[j]), b = bfhi(t[j]); s_ += a * a + b * b; }
  return s_; }
DEVI int perm16(int i) { return (i & ~12) | ((i & 4) << 1) | ((i & 8) >> 1); }

#define XB_TMO      128
#define XB_XCNT(j)  (256  + 64 * (j))
#define XB_XSUB(j)  (1280 + 64 * (j))
#define XB_XGEN(j)  (2304 + 64 * (j))
#define XB_TOP      3328
#define XB_TOPGEN   3392
#define XCD_BAR_WORDS 3456
#define XB_SPIN_CAP (1u << 20)
#define LAS __attribute__((address_space(3)))
DEVI unsigned xb_ld(unsigned* p)              { return __hip_atomic_load(p, __ATOMIC_RELAXED, __HIP_MEMORY_SCOPE_AGENT); }
DEVI unsigned xb_add(unsigned* p, unsigned v) { return __hip_atomic_fetch_add(p, v, __ATOMIC_RELAXED, __HIP_MEMORY_SCOPE_AGENT); }
DEVI unsigned xb_xcc_id() { return (unsigned)__builtin_amdgcn_s_getreg((3 << 11) | 20) & 0xFu; }
#define XB_SPIN(cond, bar) do { unsigned _sp = 0; while (cond) { __builtin_amdgcn_s_sleep(1); \
    if ((++_sp & 255u) == 0u) { if (xb_ld(&(bar)[XB_TMO])) break; if (_sp > XB_SPIN_CAP) { atomicAdd(&(bar)[XB_TMO], 1u); break; } } } } while (0)
struct XcdBarrier { unsigned* bar; unsigned x; volatile LAS unsigned* st; };
DEVI XcdBarrier xcd_barrier_post(unsigned* bar, volatile LAS unsigned* st) {
  XcdBarrier b; b.bar = bar; b.x = xb_xcc_id(); b.st = st;
  if (threadIdx.x == 0) (void)xb_add(&bar[XB_XCNT(b.x)], 1u);
  return b;
}
DEVI void xcd_barrier_complete(unsigned* bar, unsigned x, unsigned& nloc, unsigned& nx) {
  const unsigned G = gridDim.x * gridDim.y * gridDim.z;
  unsigned sum, cnt, mine, sp = 0u;
  for (;;) {
    sum = 0u; cnt = 0u; mine = 0u;
#pragma unroll
    for (unsigned j = 0; j < 16; ++j) { const unsigned c = xb_ld(&bar[XB_XCNT(j)]); sum += c; cnt += (c > 0u) ? 1u : 0u; mine = (j == x) ? c : mine; }
    if (sum == G) break;
    __builtin_amdgcn_s_sleep(1);
    if ((++sp & 255u) == 0u) { if (xb_ld(&bar[XB_TMO])) break; if (sp > XB_SPIN_CAP) { atomicAdd(&bar[XB_TMO], 1u); break; } }
  }
  nloc = mine > 0u ? mine : 1u; nx = cnt > 0u ? cnt : 1u;
}
DEVI void xcd_barrier(const XcdBarrier& b) {
  asm volatile("s_waitcnt vmcnt(0)" ::: "memory");
  __syncthreads();
  if (threadIdx.x == 0) {
    unsigned* bar = b.bar;
    __builtin_amdgcn_s_waitcnt(0);
    unsigned nloc = b.st[0], nx = b.st[1];
    if (nloc == 0u) { xcd_barrier_complete(bar, b.x, nloc, nx); b.st[0] = nloc; b.st[1] = nx; }
    const unsigned old = xb_add(&bar[XB_XSUB(b.x)], 1u);
    const unsigned gen = old / nloc;
    if (old + 1u == (gen + 1u) * nloc) {
      __builtin_amdgcn_fence(__ATOMIC_RELEASE, "agent");
      asm volatile("s_waitcnt vmcnt(0)" ::: "memory");
      const unsigned og = xb_add(&bar[XB_TOP], 1u);
      const unsigned tg = og / nx;
      if (og + 1u == (tg + 1u) * nx) xb_add(&bar[XB_TOPGEN], 1u);
      else XB_SPIN(xb_ld(&bar[XB_TOPGEN]) == tg, bar);
      __builtin_amdgcn_fence(__ATOMIC_ACQUIRE, "agent");
      xb_add(&bar[XB_XGEN(b.x)], 1u);
      asm volatile("s_waitcnt vmcnt(0)" ::: "memory");
    } else {
      XB_SPIN(xb_ld(&bar[XB_XGEN(b.x)]) == gen, bar);
      __builtin_amdgcn_fence(__ATOMIC_ACQUIRE, "agent");
      asm volatile("s_waitcnt vmcnt(0)" ::: "memory");
    }
  }
  __syncthreads();
}

struct Params;
typedef const __attribute__((address_space(4))) Params* PP;
DEVI int tidx_() { int t; asm volatile("v_mov_b32 %0, %1" : "=v"(t) : "v"((int)threadIdx.x)); return t; }
DEVI int bidx_() { int t; asm volatile("s_mov_b32 %0, %1" : "=s"(t) : "s"((int)blockIdx.x)); return t; }
DEVI int gdim_() { int t; asm volatile("s_mov_b32 %0, %1" : "=s"(t) : "s"((int)gridDim.x)); return t; }
#define TIDX tidx_()
#define BIDX bidx_()
#define GDIM gdim_()
struct Params {
  const float *x, *c, *ctx, *c_ctx, *ada_w, *ada_b, *norm1_w, *norm2_w, *w_in, *b_in, *conv_w, *conv_b, *ml_norm_w,
      *qa_norm, *wq_b, *kva_norm, *wkv_b, *qn_w, *kn_w, *ret_norm_w, *w_branch, *w_out, *router_w, *w1, *w3, *w2;
  float* out;
  unsigned* bar; unsigned* ctr;
  u16 *Wt_in, *Wt_qb, *Wt_kvb, *Wt_br, *Wt_out, *We13, *We2;
  float *mod, *rope, *xw, *gates;
  u16 *hb, *P, *Q, *K, *Vt, *ya, *yb, *yc;
  float *dC, *dN, *dM, *nin, *min_, *dR;
  u16 *Cin, *Rin;
  float *aff, *rgate, *attb;
  int *ridx, *sel;
  u16 *hid, *Y, *Xg;
};

DEVI int row_cond(int r) { return r < TL ? (r >> 13) : 2; }
DEVI const float* xin_row(PP p, int l, int r) {
  if (l == 0) return r < TL ? p->x + (size_t)r * DM : p->ctx + (size_t)(r - TL) * DM;
  return p->xw + (size_t)r * DM;
}
DEVI const float* modp(PP p, int l, int cond, int chunk) { return p->mod + ((size_t)(l * 3 + cond) * 6 + chunk) * DM; }

constexpr int GBK = 64, GLD = 72;

template <int WM, int WN, int MT, int NT>
struct GemmT {
  static constexpr int BM = WM * MT * 32, BN = WN * NT * 32;
  static constexpr int XCH = BM * 8 / NTHR, WCH = (BN * 8 + NTHR - 1) / NTHR;
  static constexpr int STAGE = (BM + BN) * GLD;
  static_assert(WM * WN == 8, "8 waves");
  static_assert(2 * STAGE * 2 <= LDS_BYTES - 64, "LDS");

  template <class XRow, bool SSQ = false>
  static DEVI void kloop(f32x16 (&acc)[MT][NT], const XRow& xrow, const u16* __restrict__ wbase, int wld, int K, u16* sm, float* ssq = nullptr) {
    const int tid = TIDX, lane = tid & 63, wid = tid >> 6, c = lane & 31, hh = lane >> 5;
    const int wm = wid / WN, wn = wid % WN;
    const u16* xp[XCH]; const u16* wp[WCH];
#pragma unroll
    for (int i = 0; i < XCH; ++i) { const int ch = tid + i * NTHR; xp[i] = xrow(ch >> 3) + (ch & 7) * 8; }
#pragma unroll
    for (int i = 0; i < WCH; ++i) { const int ch = tid + i * NTHR; const int rr = (ch >> 3) < BN ? (ch >> 3) : BN - 1; wp[i] = wbase + (size_t)rr * wld + (ch & 7) * 8; }
    u32x4 xr0[XCH], wr0[WCH], xr1[XCH], wr1[WCH];
    const int nk = K / GBK;
    float ssq_ = 0.f;
#define G_LOAD(XR, WR, kt) do { _Pragma("unroll") for (int i = 0; i < XCH; ++i) XR[i] = *reinterpret_cast<const u32x4*>(xp[i] + (kt) * GBK); \
      _Pragma("unroll") for (int i = 0; i < WCH; ++i) WR[i] = *reinterpret_cast<const u32x4*>(wp[i] + (kt) * GBK); } while (0)
#define G_WRITE(XR, WR, st) do { u16* xs_ = sm + (st) * STAGE; u16* ws_ = xs_ + BM * GLD; \
      _Pragma("unroll") for (int i = 0; i < XCH; ++i) { const int ch = tid + i * NTHR; *reinterpret_cast<u32x4*>(xs_ + (ch >> 3) * GLD + (ch & 7) * 8) = XR[i]; } \
      _Pragma("unroll") for (int i = 0; i < WCH; ++i) { const int ch = tid + i * NTHR; if ((ch >> 3) < BN) *reinterpret_cast<u32x4*>(ws_ + (ch >> 3) * GLD + (ch & 7) * 8) = WR[i]; } } while (0)
    auto compute = [&](int st) {
      const u16* xs = sm + st * STAGE + (wm * MT * 32 + c) * GLD + hh * 8;
      const u16* ws = sm + st * STAGE + BM * GLD + (wn * NT * 32 + c) * GLD + hh * 8;
#pragma unroll
      for (int ks = 0; ks < GBK / 16; ++ks) {
        bf16x8 xf[MT], wf[NT];
#pragma unroll
        for (int m = 0; m < MT; ++m) xf[m] = ld_frag(xs + m * 32 * GLD + ks * 16);
#pragma unroll
        for (int n = 0; n < NT; ++n) wf[n] = ld_frag(ws + n * 32 * GLD + ks * 16);
#pragma unroll
        for (int m = 0; m < MT; ++m)
#pragma unroll
          for (int n = 0; n < NT; ++n) acc[m][n] = mfma(wf[n], xf[m], acc[m][n]);
        if constexpr (SSQ) { const u32x4 t_ = __builtin_bit_cast(u32x4, xf[0]); ssq_ += sumsq8_(t_); }
      }
    };
    G_LOAD(xr0, wr0, 0); G_WRITE(xr0, wr0, 0);
    if (nk > 1) G_LOAD(xr0, wr0, 1);
    __syncthreads();
    for (int kt = 0; kt < nk; kt += 2) {
      if (kt + 2 < nk) G_LOAD(xr1, wr1, kt + 2);
      compute(0);
      if (kt + 1 < nk) G_WRITE(xr0, wr0, 1);
      __syncthreads();
      if (kt + 1 >= nk) break;
      if (kt + 3 < nk) G_LOAD(xr0, wr0, kt + 3);
      compute(1);
      if (kt + 2 < nk) G_WRITE(xr1, wr1, 0);
      __syncthreads();
    }
#undef G_LOAD
#undef G_WRITE
    if constexpr (SSQ) *ssq = ssq_;
  }
};
typedef GemmT<4, 2, 2, 2> GemmA;
typedef GemmT<8, 1, 1, 3> GemmQ;
typedef GemmT<8, 1, 1, 4> GemmKV;

struct XRowLin { const u16* base; size_t ld; DEVI const u16* operator()(int r) const { return base + (size_t)r * ld; } };
struct XRowIdx { const u16* base; const int* idx; DEVI const u16* operator()(int r) const { return base + (size_t)idx[r] * DM; } };

template <int MT, int NT> DEVI void zero_acc(f32x16 (&acc)[MT][NT]) {
#pragma unroll
  for (int m = 0; m < MT; ++m)
#pragma unroll
    for (int n = 0; n < NT; ++n)
#pragma unroll
      for (int i = 0; i < 16; ++i) acc[m][n][i] = 0.f;
}
DEVI void st_bf4(u16* p, float a, float b, float c, float d) { u32x2 v = {cvtpk(a, b), cvtpk(c, d)}; *reinterpret_cast<u32x2*>(p) = v; }


namespace fg {
constexpr int BM = 256, BK = 64, HALF = 128, HTB = HALF * BK * 2, STAGE_BYTES = 8 * HTB, NXCD = 8, WGM = 8;
DEVI int lds_byte(int r, int c) { const int st = (r >> 4) * 2 + (c >> 5), rr = r & 15, cc = c & 31, ob = rr * 64 + cc * 2; return st * 1024 + (ob ^ (((ob >> 9) & 1) << 5)); }
DEVI void stage_rc(int b, int& R, int& C) { const int st = b / 1024, sb = b % 1024, swz = sb ^ (((sb >> 9) & 1) << 5); R = (st >> 1) * 16 + swz / 64; C = (st & 1) * 32 + (swz % 64) / 2; }
DEVI int perm32(int rho) { const int n = rho >> 4, i = rho & 15; return 8 * (i >> 2) + 4 * n + (i & 3); }
struct Unit { int pm, pn; };
struct Gemm { const u16* A; const u16* Bt; int K; const int* gidx; };
struct StaticOrder {
  int nM, nN, nwg, G, c;
  DEVI void init(int nM_, int nN_, int G_, int c_) { nM = nM_; nN = nN_; nwg = nM * nN; G = G_; c = c_; }
  DEVI bool next(int i, Unit& u) const {
    const long L = (long)i * G + c; if (L >= nwg) return false;
    int wgid = (int)L; { const int q = nwg / NXCD, r = nwg % NXCD, xcd = wgid % NXCD, off = wgid / NXCD; wgid = (xcd < r ? xcd * (q + 1) : r * (q + 1) + (xcd - r) * q) + off; }
    const int nig = WGM * nN, gid = wgid / nig, fm = gid * WGM, gsz = (nM - fm) < WGM ? (nM - fm) : WGM;
    u.pm = fm + ((wgid % nig) % gsz); u.pn = (wgid % nig) / gsz; return true;
  }
};
struct ExpertOrder {
  int mE, nE, strideM, total, G, c;
  DEVI void init(int mE_, int nE_, int strideM_, int G_, int c_) { mE = mE_; nE = nE_; strideM = strideM_; total = NE * mE * nE; G = G_; c = c_; }
  DEVI bool next(int i, Unit& u) const {
    const int L = i * G + c; if (L >= total) return false;
    const int e = L / (mE * nE), r = L % (mE * nE);
    u.pm = e * strideM + r % mE; u.pn = e * nE + r / mE; return true;
  }
};

template <class Epi, class Sched, bool GATHER = false>
DEVI void gemm_phase(LAS unsigned char* lds, const Gemm g, const Sched& S, const Epi& E) {
  const int tid = TIDX, wid = __builtin_amdgcn_readfirstlane(tid >> 6), lane = tid & 63, wr = wid >> 2, wc = wid & 3, fr = lane & 15, fq = lane >> 4;
  const int K = g.K, nt = K / BK;
  unsigned voffA[2], voffB[2];
#pragma unroll
  for (int i = 0; i < 2; ++i) { int R, C; stage_rc(tid * 16 + i * 8192, R, C); const int Rb = Epi::PERM ? ((R & ~31) + perm32(R & 31)) : R;
    voffA[i] = (unsigned)(R * K + C) * 2u; voffB[i] = (unsigned)(Rb * K + C) * 2u; }
  unsigned gc[2][2], gn[2][2]; int gR[2]; unsigned gCb[2];
  if constexpr (GATHER) {
#pragma unroll
    for (int i = 0; i < 2; ++i) { int R, C; stage_rc(tid * 16 + i * 8192, R, C); gR[i] = R; gCb[i] = (unsigned)C * 2u; }
  }
#define FG_GOFFS(pm_, O) do { _Pragma("unroll") for (int _h = 0; _h < 2; ++_h) _Pragma("unroll") for (int _i = 0; _i < 2; ++_i) \
    O[_h][_i] = (unsigned)g.gidx[(pm_) * BM + _h * HALF + gR[_i]] * (unsigned)(K * 2) + gCb[_i]; } while (0)
#define FG_STAGE_G(bufoff, o0, o1, kb) do { \
    __builtin_amdgcn_global_load_lds((const unsigned*)((const char*)g.A + (size_t)(kb) + (o0)), (LAS unsigned*)(lds + (bufoff) + ldsw), 16, 0, 0); \
    __builtin_amdgcn_global_load_lds((const unsigned*)((const char*)g.A + (size_t)(kb) + (o1)), (LAS unsigned*)(lds + (bufoff) + ldsw + 8192), 16, 0, 0); } while (0)
  const size_t kstep = (size_t)(BK * 2);
  const size_t hstep = (size_t)HALF * K * 2;
  const size_t tstep = 2 * hstep;
  const unsigned ldsw = (unsigned)wid * 1024u;
  const int aoff = lds_byte(wr * 64 + fr, fq * 8), boff = lds_byte(wc * 32 + fr, fq * 8);
#define FG_SA(b, h) (((b) * 2 + (h)) * HTB)
#define FG_SB(b, h) ((4 + (b) * 2 + (h)) * HTB)
#define FG_STAGE(bufoff, gbase, voff) do { _Pragma("unroll") for (int _i = 0; _i < 2; ++_i) \
    __builtin_amdgcn_global_load_lds((const unsigned*)((const char*)(gbase) + (voff)[_i]), (LAS unsigned*)(lds + (bufoff) + ldsw + _i * 8192), 16, 0, 0); } while (0)
#define FG_LDA(dst, b, h) do { _Pragma("unroll") for (int m = 0; m < 4; ++m) _Pragma("unroll") for (int k = 0; k < 2; ++k) dst[m][k] = *(const LAS bf16x8*)(lds + FG_SA(b, h) + aoff + m * 2048 + k * 1024); } while (0)
#define FG_LDB(dst, b, h) do { _Pragma("unroll") for (int n = 0; n < 2; ++n) _Pragma("unroll") for (int k = 0; k < 2; ++k) dst[n][k] = *(const LAS bf16x8*)(lds + FG_SB(b, h) + boff + n * 2048 + k * 1024); } while (0)
#define FG_MMA(ai, bj, At, Bt) do { __builtin_amdgcn_s_setprio(1); _Pragma("unroll") for (int m = 0; m < 4; ++m) _Pragma("unroll") for (int n = 0; n < 2; ++n) _Pragma("unroll") for (int k = 0; k < 2; ++k) \
    acc[ai][bj][m][n] = __builtin_amdgcn_mfma_f32_16x16x32_bf16(Bt[n][k], At[m][k], acc[ai][bj][m][n], 0, 0, 0); __builtin_amdgcn_s_setprio(0); } while (0)
#define FG_WAIT_V(n) asm volatile("s_waitcnt vmcnt(" #n ")" ::: "memory")
#define FG_WAIT_L(n) asm volatile("s_waitcnt lgkmcnt(" #n ")" ::: "memory")
#define FG_BAR __builtin_amdgcn_s_barrier()
#define FG_SCHED __builtin_amdgcn_sched_barrier(0)
  Unit cur, nxt; int ui = 0;
  if (!S.next(0, cur)) return;
  f32x4 acc[2][2][4][2];
#pragma unroll
  for (int a = 0; a < 2; ++a)
#pragma unroll
    for (int b = 0; b < 2; ++b)
#pragma unroll
      for (int m = 0; m < 4; ++m)
#pragma unroll
        for (int n = 0; n < 2; ++n) acc[a][b][m][n] = (f32x4){0.f, 0.f, 0.f, 0.f};
  bf16x8 At[4][2], B0[2][2], B1[2][2];
  const char* cA = (const char*)g.A + (size_t)cur.pm * tstep; const char* cB = (const char*)g.Bt + (size_t)cur.pn * tstep;
  if constexpr (GATHER) { FG_GOFFS(cur.pm, gc); }
  FG_STAGE(FG_SB(0, 0), cB, voffB);
  if constexpr (GATHER) FG_STAGE_G(FG_SA(0, 0), gc[0][0], gc[0][1], 0); else FG_STAGE(FG_SA(0, 0), cA, voffA);
  FG_STAGE(FG_SB(0, 1), cB + hstep, voffB);
  if constexpr (GATHER) FG_STAGE_G(FG_SA(0, 1), gc[1][0], gc[1][1], 0); else FG_STAGE(FG_SA(0, 1), cA + hstep, voffA);
  if (wr == 1) FG_BAR;
  FG_WAIT_V(4); FG_BAR;
  FG_STAGE(FG_SB(1, 0), cB + kstep, voffB);
  if constexpr (GATHER) FG_STAGE_G(FG_SA(1, 0), gc[0][0], gc[0][1], kstep); else FG_STAGE(FG_SA(1, 0), cA + kstep, voffA);
  FG_STAGE(FG_SB(1, 1), cB + hstep + kstep, voffB);
  FG_WAIT_V(6); FG_BAR;
  for (;;) {
    const bool has_next = S.next(ui + 1, nxt);
    const char* nA = has_next ? (const char*)g.A + (size_t)nxt.pm * tstep : cA; const char* nB = has_next ? (const char*)g.Bt + (size_t)nxt.pn * tstep : cB;
    if constexpr (GATHER) { if (has_next) { FG_GOFFS(nxt.pm, gn); } else {
#pragma unroll
        for (int _h = 0; _h < 2; ++_h) { gn[_h][0] = gc[_h][0]; gn[_h][1] = gc[_h][1]; } } }
    for (int t = 0; t < nt; t += 2) {
      const bool last = (t == nt - 2);
      const char* a1 = cA + (size_t)(t + 1) * kstep;
      const char* a2 = last ? nA : cA + (size_t)(t + 2) * kstep; const char* b2 = last ? nB : cB + (size_t)(t + 2) * kstep;
      const char* a3 = a2 + kstep; const char* b3 = b2 + kstep;
      const size_t kb1 = (size_t)(t + 1) * kstep, kb2 = last ? 0 : (size_t)(t + 2) * kstep;
      unsigned o00 = 0, o01 = 0, o10 = 0, o11 = 0;
      if constexpr (GATHER) { o00 = last ? gn[0][0] : gc[0][0]; o01 = last ? gn[0][1] : gc[0][1]; o10 = last ? gn[1][0] : gc[1][0]; o11 = last ? gn[1][1] : gc[1][1]; }
      FG_LDB(B0, 0, 0); FG_SCHED; FG_LDA(At, 0, 0); if constexpr (GATHER) FG_STAGE_G(FG_SA(1, 1), gc[1][0], gc[1][1], kb1); else FG_STAGE(FG_SA(1, 1), a1 + hstep, voffA);
      FG_WAIT_L(8); FG_BAR; FG_WAIT_L(0); FG_MMA(0, 0, At, B0); FG_BAR; FG_SCHED;
      FG_LDB(B1, 0, 1); FG_STAGE(FG_SB(0, 0), b2, voffB);
      FG_BAR; FG_WAIT_L(0); FG_MMA(0, 1, At, B1); FG_BAR;
      FG_LDA(At, 0, 1); if constexpr (GATHER) FG_STAGE_G(FG_SA(0, 0), o00, o01, kb2); else FG_STAGE(FG_SA(0, 0), a2, voffA);
      FG_BAR; FG_WAIT_L(0); FG_MMA(1, 0, At, B0); FG_BAR; FG_SCHED;
      FG_STAGE(FG_SB(0, 1), b2 + hstep, voffB);
      FG_WAIT_V(6); FG_BAR; FG_MMA(1, 1, At, B1); FG_BAR;
      FG_LDB(B0, 1, 0); FG_SCHED; FG_LDA(At, 1, 0); if constexpr (GATHER) FG_STAGE_G(FG_SA(0, 1), o10, o11, kb2); else FG_STAGE(FG_SA(0, 1), a2 + hstep, voffA);
      FG_WAIT_L(8); FG_BAR; FG_WAIT_L(0); FG_MMA(0, 0, At, B0); FG_BAR; FG_SCHED;
      FG_LDB(B1, 1, 1); FG_STAGE(FG_SB(1, 0), b3, voffB);
      FG_BAR; FG_WAIT_L(0); FG_MMA(0, 1, At, B1); FG_BAR;
      FG_LDA(At, 1, 1); if constexpr (GATHER) FG_STAGE_G(FG_SA(1, 0), o00, o01, kb2 + kstep); else FG_STAGE(FG_SA(1, 0), a3, voffA);
      FG_BAR; FG_WAIT_L(0); FG_MMA(1, 0, At, B0); FG_BAR; FG_SCHED;
      FG_STAGE(FG_SB(1, 1), b3 + hstep, voffB);
      FG_WAIT_V(6); FG_BAR; FG_MMA(1, 1, At, B1); FG_BAR;
    }
    E(acc, cur, wr, wc, fr, fq);
    if (!has_next) break;
#pragma unroll
    for (int a = 0; a < 2; ++a)
#pragma unroll
      for (int b = 0; b < 2; ++b)
#pragma unroll
        for (int m = 0; m < 4; ++m)
#pragma unroll
          for (int n = 0; n < 2; ++n) acc[a][b][m][n] = (f32x4){0.f, 0.f, 0.f, 0.f};
    cur = nxt; cA = nA; cB = nB; ++ui;
    if constexpr (GATHER) {
#pragma unroll
      for (int _h = 0; _h < 2; ++_h) { gc[_h][0] = gn[_h][0]; gc[_h][1] = gn[_h][1]; } }
  }
  FG_WAIT_V(0);
  if (wr == 0) FG_BAR;
  FG_BAR;
#undef FG_SA
#undef FG_SB
#undef FG_STAGE
#undef FG_STAGE_G
#undef FG_GOFFS
#undef FG_LDA
#undef FG_LDB
#undef FG_MMA
#undef FG_WAIT_V
#undef FG_WAIT_L
#undef FG_BAR
#undef FG_SCHED
}
typedef f32x4 Acc[2][2][4][2];

struct EpiInproj {
  static constexpr bool PERM = true;
  u16* P; float* gates; const float* bias;
  DEVI void operator()(const Acc& acc, const Unit& u, int wr, int wc, int fr, int fq) const {
    const int row0 = u.pm * BM + wr * 64 + fr, colb = u.pn * BM + wc * 32 + 8 * fq;
#pragma unroll
    for (int bj = 0; bj < 2; ++bj) {
      const int col = colb + bj * HALF;
      if (col < NIN) {
        const f32x4 b0 = *reinterpret_cast<const f32x4*>(bias + col), b1 = *reinterpret_cast<const f32x4*>(bias + col + 4);
#pragma unroll
        for (int ai = 0; ai < 2; ++ai)
#pragma unroll
          for (int m = 0; m < 4; ++m) {
            const int row = row0 + ai * HALF + m * 16;
            const f32x4 v0 = acc[ai][bj][m][0] + b0, v1 = acc[ai][bj][m][1] + b1;
            u32x4 w = {cvtpk(v0[0], v0[1]), cvtpk(v0[2], v0[3]), cvtpk(v1[0], v1[1]), cvtpk(v1[2], v1[3])};
            *reinterpret_cast<u32x4*>(P + (size_t)row * NINP + col) = w;
            if (col >= O_GATES && col < O_GATES + 32) { float* gp = gates + (size_t)row * 32 + (col - O_GATES); *reinterpret_cast<f32x4*>(gp) = v0; *reinterpret_cast<f32x4*>(gp + 4) = v1; }
          }
      }
    }
  }
};
struct EpiWout {
  static constexpr bool PERM = false;
  const float* xold; float* xw; const float* g1_0; const float* g1_1;
  DEVI void operator()(const Acc& acc, const Unit& u, int wr, int wc, int fr, int fq) const {
    const int row0 = u.pm * BM + wr * 64 + fr, col0 = u.pn * BM + wc * 32 + 4 * fq;
    const float* g1 = (u.pm * BM) < SEQ ? g1_0 : g1_1;
    f32x4 gv[2][2];
#pragma unroll
    for (int bj = 0; bj < 2; ++bj)
#pragma unroll
      for (int n = 0; n < 2; ++n) gv[bj][n] = *reinterpret_cast<const f32x4*>(g1 + col0 + bj * HALF + n * 16);
#pragma unroll
    for (int ai = 0; ai < 2; ++ai)
#pragma unroll
      for (int m = 0; m < 4; ++m) {
        const size_t off = (size_t)(row0 + ai * HALF + m * 16) * DM + col0;
#pragma unroll
        for (int bj = 0; bj < 2; ++bj)
#pragma unroll
          for (int n = 0; n < 2; ++n) { const f32x4 xv = *reinterpret_cast<const f32x4*>(xold + off + bj * HALF + n * 16);
            *reinterpret_cast<f32x4*>(xw + off + bj * HALF + n * 16) = xv + gv[bj][n] * acc[ai][bj][m][n]; }
      }
  }
};
struct EpiSwiglu {
  static constexpr bool PERM = true;
  u16* hid;
  DEVI void operator()(const Acc& acc, const Unit& u, int wr, int wc, int fr, int fq) const {
    const int row0 = u.pm * BM + wr * 64 + fr, col = (u.pn & 7) * HALF + wc * 32 + 8 * fq;
#pragma unroll
    for (int ai = 0; ai < 2; ++ai)
#pragma unroll
      for (int m = 0; m < 4; ++m) {
        float o[8];
#pragma unroll
        for (int n = 0; n < 2; ++n)
#pragma unroll
          for (int j = 0; j < 4; ++j) o[4 * n + j] = siluf_(acc[ai][0][m][n][j]) * acc[ai][1][m][n][j];
        u32x4 w = {cvtpk(o[0], o[1]), cvtpk(o[2], o[3]), cvtpk(o[4], o[5]), cvtpk(o[6], o[7])};
        *reinterpret_cast<u32x4*>(hid + (size_t)(row0 + ai * HALF + m * 16) * FF + col) = w;
      }
  }
};
struct EpiY {
  static constexpr bool PERM = true;
  u16* Y; const float* gate;
  DEVI void operator()(const Acc& acc, const Unit& u, int wr, int wc, int fr, int fq) const {
    const int row0 = u.pm * BM + wr * 64 + fr, colb = (u.pn & 3) * BM + wc * 32 + 8 * fq;
#pragma unroll
    for (int ai = 0; ai < 2; ++ai)
#pragma unroll
      for (int m = 0; m < 4; ++m) {
        const int row = row0 + ai * HALF + m * 16; const float gt = gate[row];
#pragma unroll
        for (int bj = 0; bj < 2; ++bj) {
          const f32x4 v0 = acc[ai][bj][m][0] * gt, v1 = acc[ai][bj][m][1] * gt;
          u32x4 w = {cvtpk(v0[0], v0[1]), cvtpk(v0[2], v0[3]), cvtpk(v1[0], v1[1]), cvtpk(v1[2], v1[3])};
          *reinterpret_cast<u32x4*>(Y + (size_t)row * DM + colb + bj * HALF) = w;
        }
      }
  }
};
struct MergeZOrder {
  int G, c, nM;
  DEVI void init(int G_, int c_, int nM_) { G = G_; c = c_; nM = nM_; }
  DEVI bool next(int i, Unit& u) const {
    const int L = i * G + c; if (L >= 3 * nM * 4) return false;
    const int br = L / (nM * 4), T = L % (nM * 4);
    u.pm = br * (TT / 256) + (T >> 2); u.pn = br * 4 + (T & 3); return true;
  }
};
struct EpiZ {
  static constexpr bool PERM = true;
  u16* z01; u16* z2;
  DEVI void operator()(const Acc& acc, const Unit& u, int wr, int wc, int fr, int fq) const {
    const int br = u.pn >> 2, nt = u.pn & 3, mt = u.pm - br * (TT / 256);
    u16* base = br < 2 ? z01 + (size_t)br * TT * DM : z2;
    const int row0 = mt * BM + wr * 64 + fr, colb = nt * BM + wc * 32 + 8 * fq;
#pragma unroll
    for (int ai = 0; ai < 2; ++ai)
#pragma unroll
      for (int m = 0; m < 4; ++m) {
        const int row = row0 + ai * HALF + m * 16;
#pragma unroll
        for (int bj = 0; bj < 2; ++bj) {
          const f32x4 v0 = acc[ai][bj][m][0], v1 = acc[ai][bj][m][1];
          u32x4 w = {cvtpk(v0[0], v0[1]), cvtpk(v0[2], v0[3]), cvtpk(v1[0], v1[1]), cvtpk(v1[2], v1[3])};
          *reinterpret_cast<u32x4*>(base + (size_t)row * DM + colb + bj * HALF) = w;
        }
      }
  }
};
}
typedef GemmT<2, 4, 1, 1> GemmS;

struct CvtD { const float* src; u16* dst; const float* ksc; int ldn, ldk; };
DEVI void cvt_load(const CvtD& d, f32x4 (&v)[16]) {
  const int lane = TIDX & 63, kg = lane >> 3, nq = lane & 7;
  const float* s = d.src + (size_t)(kg * 8) * d.ldn + nq * 4;
#pragma unroll
  for (int h = 0; h < 2; ++h)
#pragma unroll
    for (int i = 0; i < 8; ++i) v[h * 8 + i] = __builtin_nontemporal_load(reinterpret_cast<const f32x4*>(s + (size_t)i * d.ldn + h * 32));
}
DEVI void cvt_store(const CvtD& d, f32x4 (&v)[16]) {
  const int lane = TIDX & 63, kg = lane >> 3, nq = lane & 7;
  if (d.ksc) {
    const f32x4 s0 = *reinterpret_cast<const f32x4*>(d.ksc + kg * 8), s1 = *reinterpret_cast<const f32x4*>(d.ksc + kg * 8 + 4);
#pragma unroll
    for (int h = 0; h < 2; ++h)
#pragma unroll
      for (int i = 0; i < 8; ++i) v[h * 8 + i] *= (i < 4 ? s0[i & 3] : s1[i & 3]);
  }
  u16* o = d.dst + (size_t)(nq * 4) * d.ldk + kg * 8;
#pragma unroll
  for (int h = 0; h < 2; ++h)
#pragma unroll
    for (int j = 0; j < 4; ++j) {
      const u32x4 w = {cvtpk(v[h * 8 + 0][j], v[h * 8 + 1][j]), cvtpk(v[h * 8 + 2][j], v[h * 8 + 3][j]), cvtpk(v[h * 8 + 4][j], v[h * 8 + 5][j]), cvtpk(v[h * 8 + 6][j], v[h * 8 + 7][j])};
      __builtin_nontemporal_store(w, reinterpret_cast<u32x4*>(o + (size_t)(h * 32 + j) * d.ldk));
    }
}

constexpr int CT_IN = 16 * 115, CT_QB = 6 * 12, CT_KVB = 4 * 16, CT_BR = 3 * 8 * 16, CT_OUT = 256, CT_E13 = 16 * 2 * 256, CT_E2 = 16 * 256;
constexpr int CT_LAYER = CT_IN + CT_QB + CT_KVB + CT_BR + CT_OUT + CT_E13 + CT_E2;
constexpr int ADA_JOBS = DEPTH * 48;

DEVI CvtD cvt_desc(PP p, int l, int t) {
  CvtD d; d.ksc = nullptr;
  if (t < CT_IN) { const int kt = t / 115, nt = t % 115; d.ldn = NIN; d.ldk = DM;
    d.src = p->w_in + (size_t)l * DM * NIN + (size_t)(kt * 64) * NIN + nt * 64; d.dst = p->Wt_in + (size_t)l * NINP * DM + (size_t)(nt * 64) * DM + kt * 64; return d; }
  t -= CT_IN;
  if (t < CT_QB) { const int kt = t / 12, nt = t % 12; d.ldn = 768; d.ldk = 384; d.ksc = p->qa_norm + l * 384 + kt * 64;
    d.src = p->wq_b + (size_t)l * 384 * 768 + (size_t)(kt * 64) * 768 + nt * 64; d.dst = p->Wt_qb + (size_t)l * 768 * 384 + (size_t)(nt * 64) * 384 + kt * 64; return d; }
  t -= CT_QB;
  if (t < CT_KVB) { const int kt = t / 16, nt = t % 16; d.ldn = 1024; d.ldk = 256; d.ksc = p->kva_norm + l * 256 + kt * 64;
    d.src = p->wkv_b + (size_t)l * 256 * 1024 + (size_t)(kt * 64) * 1024 + nt * 64; d.dst = p->Wt_kvb + (size_t)l * 1024 * 256 + (size_t)(nt * 64) * 256 + kt * 64; return d; }
  t -= CT_KVB;
  if (t < CT_BR) { const int n = t / 128, r = t % 128, kt = r / 16, nt = r % 16; d.ldn = 1024; d.ldk = 512;
    d.src = p->w_branch + ((size_t)l * 3 + n) * 512 * 1024 + (size_t)(kt * 64) * 1024 + nt * 64; d.dst = p->Wt_br + ((size_t)l * 3 + n) * 1024 * 512 + (size_t)(nt * 64) * 512 + kt * 64; return d; }
  t -= CT_BR;
  if (t < CT_OUT) { const int kt = t / 16, nt = t % 16; d.ldn = DM; d.ldk = DM;
    d.src = p->w_out + (size_t)l * DM * DM + (size_t)(kt * 64) * DM + nt * 64; d.dst = p->Wt_out + (size_t)l * DM * DM + (size_t)(nt * 64) * DM + kt * 64; return d; }
  t -= CT_OUT;
  if (t < CT_E13) { const int e = t / 512, r = t % 512, which = r / 256, r2 = r % 256, kt = r2 / 16, nt = r2 % 16; d.ldn = FF; d.ldk = DM;
    const int n0 = nt * 64, drow = (n0 >> 7) * 256 + which * 128 + (n0 & 127);
    d.src = (which ? p->w3 : p->w1) + ((size_t)l * NE + e) * DM * FF + (size_t)(kt * 64) * FF + n0;
    d.dst = p->We13 + ((size_t)l * NE + e) * 2048 * DM + (size_t)drow * DM + kt * 64; return d; }
  t -= CT_E13;
  { const int e = t / 256, r = t % 256, kt = r / 16, nt = r % 16; d.ldn = DM; d.ldk = FF;
    d.src = p->w2 + ((size_t)l * NE + e) * FF * DM + (size_t)(kt * 64) * DM + nt * 64; d.dst = p->We2 + ((size_t)l * NE + e) * DM * FF + (size_t)(nt * 64) * FF + kt * 64; }
  return d;
}
constexpr int CVT_PER_JOB = 32, CVT_JOBS = (CT_LAYER + CVT_PER_JOB - 1) / CVT_PER_JOB;
DEVI void cvt_bundle(PP p, int l, int j) {
  const int t0 = j * CVT_PER_JOB, t1 = (t0 + CVT_PER_JOB) < CT_LAYER ? (t0 + CVT_PER_JOB) : CT_LAYER;
  const int tA = t0 + __builtin_amdgcn_readfirstlane(TIDX >> 6), tB = tA + 8, tC = tA + 16, tD = tA + 24;
  f32x4 a[16], b[16];
  CvtD dA, dB;
  if (tA < t1) { dA = cvt_desc(p, l, tA); cvt_load(dA, a); }
  if (tB < t1) { dB = cvt_desc(p, l, tB); cvt_load(dB, b); }
  if (tA < t1) cvt_store(dA, a);
  if (tC < t1) { dA = cvt_desc(p, l, tC); cvt_load(dA, a); }
  if (tB < t1) cvt_store(dB, b);
  if (tD < t1) { dB = cvt_desc(p, l, tD); cvt_load(dB, b); }
  if (tC < t1) cvt_store(dA, a);
  if (tD < t1) cvt_store(dB, b);
}

DEVI void ada_job(PP p, int job, float* sm) {
  const int l = job / 48, c0 = (job % 48) * 128, tid = TIDX;
  float* sv = sm;
  float* red = sm + 3 * 1024;
  __syncthreads();
  for (int i = tid; i < 3 * 1024; i += NTHR) { const int cd = i >> 10, k = i & 1023; const float v = cd < 2 ? p->c[cd * DM + k] : p->c_ctx[k]; sv[i] = siluf_(v); }
  __syncthreads();
  const int cg = tid & 31, ksp = tid >> 5;
  f32x4 a0 = {0, 0, 0, 0}, a1 = a0, a2 = a0;
  const float* wp = p->ada_w + (size_t)l * DM * 6144 + (size_t)(ksp * 64) * 6144 + c0 + cg * 4;
#pragma unroll 8
  for (int k = 0; k < 64; ++k) {
    const f32x4 w = *reinterpret_cast<const f32x4*>(wp + (size_t)k * 6144);
    const int kk = ksp * 64 + k;
    a0 += w * sv[kk]; a1 += w * sv[1024 + kk]; a2 += w * sv[2048 + kk];
  }
#pragma unroll
  for (int j = 0; j < 4; ++j) { red[(ksp * 3 + 0) * 128 + cg * 4 + j] = a0[j]; red[(ksp * 3 + 1) * 128 + cg * 4 + j] = a1[j]; red[(ksp * 3 + 2) * 128 + cg * 4 + j] = a2[j]; }
  __syncthreads();
  if (tid < 384) { const int cd = tid >> 7, col = tid & 127; float s = p->ada_b[l * 6144 + c0 + col];
#pragma unroll
    for (int k = 0; k < 16; ++k) s += red[(k * 3 + cd) * 128 + col];
    p->mod[(size_t)(l * 3 + cd) * 6144 + c0 + col] = s; }
}

DEVI void phase_prologue(PP p, char* smem) {
  float* sm = reinterpret_cast<float*>(smem);
  for (int j = BIDX; j < ADA_JOBS + 1; j += GDIM) {
    if (j < ADA_JOBS) ada_job(p, j, sm);
    else {
      if (TIDX < DEPTH) { float gq = 0.f, gk = 0.f; for (int d = 0; d < 96; ++d) { gq = fmaxf(gq, fabsf(p->qn_w[TIDX * 96 + d])); gk = fmaxf(gk, fabsf(p->kn_w[TIDX * 96 + d])); }
        p->attb[TIDX] = 96.f * gq * gk * 0.10206207261596575f * LOG2E * 1.02f; }
      for (int i = TIDX; i < 128 * 8; i += NTHR) { const int pos = i >> 3, f = i & 7;
        const float inv = powf(10000.f, -(float)f / 8.f); const float a = (float)pos * inv;
        p->rope[i * 2] = cosf(a); p->rope[i * 2 + 1] = sinf(a); }
    }
  }
  __syncthreads();
  for (int j = (BIDX + 192) % GDIM; j < CVT_JOBS; j += GDIM) cvt_bundle(p, 0, j);
}

template <bool COMBINE, bool FINAL>
DEVI void phase_norm1(PP p, int l) {
  const int lane = TIDX & 63, gw = BIDX * 8 + (TIDX >> 6), nw = GDIM * 8;
  const int nrows = FINAL ? TL : TT;
  const int r0 = (int)((long)gw * nrows / nw), r1 = (int)((long)(gw + 1) * nrows / nw);
  int cur = -1;
  f32x4 Wm[4], Ad[4], G2[4];
  f32x4 nx[4]; int nsv = -1;
  if (r0 < r1) { const float* xr = xin_row(p, l, r0);
#pragma unroll
    for (int i = 0; i < 4; ++i) nx[i] = *reinterpret_cast<const f32x4*>(xr + i * 256 + lane * 4);
    if (COMBINE) nsv = p->sel[(size_t)r0 * 16 + (lane & 15)]; }
  for (int r = r0; r < r1; ++r) {
    f32x4 v[4];
#pragma unroll
    for (int i = 0; i < 4; ++i) v[i] = nx[i];
    const int sv = nsv;
    if (r + 1 < r1) { const float* xr = xin_row(p, l, r + 1);
#pragma unroll
      for (int i = 0; i < 4; ++i) nx[i] = *reinterpret_cast<const f32x4*>(xr + i * 256 + lane * 4);
      if (COMBINE) nsv = p->sel[(size_t)(r + 1) * 16 + (lane & 15)]; }
    const int cond = row_cond(r);
    if (cond != cur) {
      cur = cond;
      if (COMBINE) { const float* g2 = modp(p, l - 1, cond, 5);
#pragma unroll
        for (int i = 0; i < 4; ++i) G2[i] = *reinterpret_cast<const f32x4*>(g2 + i * 256 + lane * 4); }
      if (!FINAL) { const float* nw_ = p->norm1_w + l * DM; const float* sc = modp(p, l, cond, 1); const float* sh = modp(p, l, cond, 0);
#pragma unroll
        for (int i = 0; i < 4; ++i) { const int col = i * 256 + lane * 4;
          Wm[i] = *reinterpret_cast<const f32x4*>(nw_ + col) * (1.f + *reinterpret_cast<const f32x4*>(sc + col)); Ad[i] = *reinterpret_cast<const f32x4*>(sh + col); } }
    }
    if (COMBINE) {
      f32x4 a[4];
#pragma unroll
      for (int i = 0; i < 4; ++i) a[i] = (f32x4){0.f, 0.f, 0.f, 0.f};
#pragma unroll
      for (int e = 0; e < 16; ++e) {
        const int s = __builtin_amdgcn_readlane(sv, e);
        if (s >= 0) {
          const u16* y = p->Y + ((size_t)e * ESLOTS + s) * DM;
#pragma unroll
          for (int i = 0; i < 4; ++i) { const u32x2 t = *reinterpret_cast<const u32x2*>(y + i * 256 + lane * 4);
            a[i] += (f32x4){bflo(t.x), bfhi(t.x), bflo(t.y), bfhi(t.y)}; }
        }
      }
#pragma unroll
      for (int i = 0; i < 4; ++i) v[i] += G2[i] * a[i];
      float* dst = FINAL ? p->out + (size_t)r * DM : p->xw + (size_t)r * DM;
#pragma unroll
      for (int i = 0; i < 4; ++i) *reinterpret_cast<f32x4*>(dst + i * 256 + lane * 4) = v[i];
    }
    if (!FINAL) {
      float ss = 0.f;
#pragma unroll
      for (int i = 0; i < 4; ++i) ss += v[i][0] * v[i][0] + v[i][1] * v[i][1] + v[i][2] * v[i][2] + v[i][3] * v[i][3];
      ss = wave_sum(ss);
      const float rstd = rsqrtf(ss * (1.f / DM) + EPS);
#pragma unroll
      for (int i = 0; i < 4; ++i) { const int col = i * 256 + lane * 4;
        const f32x4 h = v[i] * rstd * Wm[i] + Ad[i];
        st_bf4(p->hb + (size_t)r * DM + col, h[0], h[1], h[2], h[3]); }
    }
  }
}

DEVI void phase_inproj(PP p, int l, char* smem) {
  fg::StaticOrder S; S.init(TT / 256, NINP / 256, GDIM, BIDX);
  fg::Gemm g{p->hb, p->Wt_in + (size_t)l * NINP * DM, DM, nullptr};
  fg::EpiInproj E{p->P, p->gates, p->b_in + (size_t)l * NIN};
  __syncthreads();
  fg::gemm_phase((LAS unsigned char*)(smem), g, S, E);
}

DEVI float sumsq8(u32x4 t) {
  float s = 0.f;
#pragma unroll
  for (int j = 0; j < 4; ++j) { const float a = bflo(t[j]), b = bfhi(t[j]); s += a * a + b * b; }
  return s;
}
DEVI void rope_sub(f32x16& a, const float* rope, int t, int hh) {
  const int pr = t >> 6, pc = t & 63;
  const f32x4 r0 = *reinterpret_cast<const f32x4*>(rope + (pr * 8 + 4 * hh) * 2), r1 = *reinterpret_cast<const f32x4*>(rope + (pr * 8 + 4 * hh) * 2 + 4);
  const f32x4 c0 = *reinterpret_cast<const f32x4*>(rope + (pc * 8 + 4 * hh) * 2), c1 = *reinterpret_cast<const f32x4*>(rope + (pc * 8 + 4 * hh) * 2 + 4);
  const float rc[4] = {r0[0], r0[2], r1[0], r1[2]}, rs[4] = {r0[1], r0[3], r1[1], r1[3]};
  const float cc[4] = {c0[0], c0[2], c1[0], c1[2]}, cs[4] = {c0[1], c0[3], c1[1], c1[3]};
#pragma unroll
  for (int j = 0; j < 4; ++j) {
    const float x1 = a[j], x2 = a[4 + j];
    a[j] = x1 * rc[j] - x2 * rs[j]; a[4 + j] = x1 * rs[j] + x2 * rc[j];
    const float y1 = a[8 + j], y2 = a[12 + j];
    a[8 + j] = y1 * cc[j] - y2 * cs[j]; a[12 + j] = y1 * cs[j] + y2 * cc[j];
  }
}

DEVI void mlaq_unit(PP p, int l, int mt, int head, u16* sm) {
  const int lane = TIDX & 63, wid = TIDX >> 6, c = lane & 31, hh = lane >> 5;
  f32x16 acc[1][3]; zero_acc(acc);
  XRowLin xr{p->P + (size_t)mt * 256 * NINP + O_QLAT, (size_t)NINP};
  float ss = 0.f;
  GemmQ::kloop<XRowLin, true>(acc, xr, p->Wt_qb + (size_t)l * 768 * 384 + (size_t)head * 96 * 384, 384, 384, sm, &ss);
  const int row = mt * 256 + wid * 32 + c;
  ss = sum32(ss);
  const float rstd = rsqrtf(ss * (1.f / 384.f) + EPS);
  float s2 = 0.f;
#pragma unroll
  for (int n = 0; n < 3; ++n)
#pragma unroll
    for (int i = 0; i < 16; ++i) { acc[0][n][i] *= rstd; s2 += acc[0][n][i] * acc[0][n][i]; }
  s2 = sum32(s2);
  const float r2 = rsqrtf(s2 * (1.f / 96.f) + EPS);
  const float* qw = p->qn_w + l * 96;
#pragma unroll
  for (int n = 0; n < 3; ++n)
#pragma unroll
    for (int g = 0; g < 4; ++g) { const f32x4 w = *reinterpret_cast<const f32x4*>(qw + 32 * n + 8 * g + 4 * hh);
#pragma unroll
      for (int j = 0; j < 4; ++j) acc[0][n][4 * g + j] *= r2 * w[j]; }
  if (row < TL) rope_sub(acc[0][2], p->rope, row & (SEQ - 1), hh);
  const float qs = 0.10206207261596575f * LOG2E;
  u16* dst = p->Q + (size_t)row * 768 + head * 96;
#pragma unroll
  for (int n = 0; n < 3; ++n)
#pragma unroll
    for (int g = 0; g < 4; ++g) st_bf4(dst + 32 * n + 8 * g + 4 * hh, acc[0][n][4 * g] * qs, acc[0][n][4 * g + 1] * qs, acc[0][n][4 * g + 2] * qs, acc[0][n][4 * g + 3] * qs);
}

DEVI void mlakv_unit(PP p, int l, int mt, int head, u16* sm) {
  const int lane = TIDX & 63, wid = TIDX >> 6, c = lane & 31, hh = lane >> 5;
  f32x16 acc[1][4]; zero_acc(acc);
  XRowLin xr{p->P + (size_t)mt * 256 * NINP + O_KVLAT, (size_t)NINP};
  float ss = 0.f;
  GemmKV::kloop<XRowLin, true>(acc, xr, p->Wt_kvb + (size_t)l * 1024 * 256 + (size_t)head * 128 * 256, 256, 256, sm, &ss);
  const int row = mt * 256 + wid * 32 + c;
  ss = sum32(ss);
  const float rstd = rsqrtf(ss * (1.f / 256.f) + EPS);
  f32x16 kr;
  const u16* krp = p->P + (size_t)row * NINP + O_KROPE + 4 * hh;
#pragma unroll
  for (int g = 0; g < 4; ++g) { const u32x2 t = *reinterpret_cast<const u32x2*>(krp + 8 * g);
    kr[4 * g] = bflo(t.x); kr[4 * g + 1] = bfhi(t.x); kr[4 * g + 2] = bflo(t.y); kr[4 * g + 3] = bfhi(t.y); }
  float s2 = 0.f;
#pragma unroll
  for (int n = 0; n < 4; ++n)
#pragma unroll
    for (int i = 0; i < 16; ++i) { acc[0][n][i] *= rstd; if (n < 2) s2 += acc[0][n][i] * acc[0][n][i]; }
#pragma unroll
  for (int i = 0; i < 16; ++i) s2 += kr[i] * kr[i];
  s2 = sum32(s2);
  const float r2 = rsqrtf(s2 * (1.f / 96.f) + EPS);
  const float* kw = p->kn_w + l * 96;
#pragma unroll
  for (int g = 0; g < 4; ++g) {
    const f32x4 w0 = *reinterpret_cast<const f32x4*>(kw + 8 * g + 4 * hh), w1 = *reinterpret_cast<const f32x4*>(kw + 32 + 8 * g + 4 * hh), w2 = *reinterpret_cast<const f32x4*>(kw + 64 + 8 * g + 4 * hh);
#pragma unroll
    for (int j = 0; j < 4; ++j) { acc[0][0][4 * g + j] *= r2 * w0[j]; acc[0][1][4 * g + j] *= r2 * w1[j]; kr[4 * g + j] *= r2 * w2[j]; }
  }
  int b, key;
  if (row < TL) { b = row >> 13; key = CTXL + (row & (SEQ - 1)); rope_sub(kr, p->rope, row & (SEQ - 1), hh); }
  else { b = (row - TL) >> 8; key = (row - TL) & (CTXL - 1); }
  u16* dst = p->K + ((size_t)b * KEYS + key) * 768 + head * 96;
#pragma unroll
  for (int g = 0; g < 4; ++g) {
    st_bf4(dst + 8 * g + 4 * hh, acc[0][0][4 * g], acc[0][0][4 * g + 1], acc[0][0][4 * g + 2], acc[0][0][4 * g + 3]);
    st_bf4(dst + 32 + 8 * g + 4 * hh, acc[0][1][4 * g], acc[0][1][4 * g + 1], acc[0][1][4 * g + 2], acc[0][1][4 * g + 3]);
    st_bf4(dst + 64 + 8 * g + 4 * hh, kr[4 * g], kr[4 * g + 1], kr[4 * g + 2], kr[4 * g + 3]);
  }
  const int kpos = (key & ~15) | perm16(key & 15);
  u16* vdst = p->Vt + ((size_t)(b * 8 + head) * 64) * KEYS + kpos;
#pragma unroll
  for (int n = 0; n < 2; ++n)
#pragma unroll
    for (int i = 0; i < 16; ++i) vdst[(size_t)(32 * n + crow(i, hh)) * KEYS] = f2bf(acc[0][2 + n][i]);
}

constexpr int AK_LD = 104, AV_LD = 72, ATT_STAGE = 64 * AK_LD + 64 * AV_LD;
template <bool FAST>
DEVI void attn_unit(PP p, int b, int head, int q0row, int nkeys, u16* sm) {
  const int tid = TIDX, lane = tid & 63, wid = tid >> 6, c = lane & 31, hh = lane >> 5;
  const int row = q0row + wid * 32 + c;
  bf16x8 qf[6];
#pragma unroll
  for (int s = 0; s < 6; ++s) qf[s] = ld_frag(p->Q + (size_t)row * 768 + head * 96 + s * 16 + hh * 8);
  f32x16 o[2], negm;
#pragma unroll
  for (int i = 0; i < 16; ++i) { o[0][i] = 0.f; o[1][i] = 0.f; negm[i] = 0.f; }
  float lsum = 0.f;
  const u16* Kg = p->K + (size_t)b * KEYS * 768 + head * 96;
  const u16* Vg = p->Vt + (size_t)(b * 8 + head) * 64 * KEYS;
  const int id1 = 512 + tid;
  const bool s1k = id1 < 768;
  const u16* g0 = Kg + (size_t)(tid / 12) * 768 + (tid % 12) * 8;
  const int l0 = (tid / 12) * AK_LD + (tid % 12) * 8;
  const u16* g1 = s1k ? Kg + (size_t)(id1 / 12) * 768 + (id1 % 12) * 8 : Vg + (size_t)((id1 - 768) >> 3) * KEYS + ((id1 - 768) & 7) * 8;
  const int l1 = s1k ? (id1 / 12) * AK_LD + (id1 % 12) * 8 : 64 * AK_LD + ((id1 - 768) >> 3) * AV_LD + ((id1 - 768) & 7) * 8;
  const size_t st1 = s1k ? (size_t)64 * 768 : 64;
  const int id2 = 256 + tid;
  const u16* g2 = Vg + (size_t)(id2 >> 3) * KEYS + (id2 & 7) * 8;
  const int l2 = 64 * AK_LD + (id2 >> 3) * AV_LD + (id2 & 7) * 8;
  u32x4 r0, r1, r2;
  auto gload = [&](int j) {
    r0 = *reinterpret_cast<const u32x4*>(g0 + (size_t)j * 64 * 768);
    r1 = *reinterpret_cast<const u32x4*>(g1 + (size_t)j * st1);
    if (tid < 256) r2 = *reinterpret_cast<const u32x4*>(g2 + (size_t)j * 64);
  };
  auto swrite = [&](int st) {
    u16* s = sm + st * ATT_STAGE;
    *reinterpret_cast<u32x4*>(s + l0) = r0; *reinterpret_cast<u32x4*>(s + l1) = r1;
    if (tid < 256) *reinterpret_cast<u32x4*>(s + l2) = r2;
  };
  const int NT = nkeys / 64;
  __syncthreads();
  gload(0); swrite(0); __syncthreads();
  for (int j = 0; j < NT; ++j) {
    if (j + 1 < NT) gload(j + 1);
    const u16* Ks = sm + (j & 1) * ATT_STAGE; const u16* Vs = Ks + 64 * AK_LD;
    f32x16 s0 = negm, s1 = negm;
    {
      const u16* k0p = Ks + c * AK_LD + hh * 8; const u16* k1p = Ks + (32 + c) * AK_LD + hh * 8;
      bf16x8 fa[4], fb[4];
      fa[0] = ld_frag(k0p); fa[1] = ld_frag(k1p); fa[2] = ld_frag(k0p + 16); fa[3] = ld_frag(k1p + 16);
      fb[0] = ld_frag(k0p + 32); fb[1] = ld_frag(k1p + 32); fb[2] = ld_frag(k0p + 48); fb[3] = ld_frag(k1p + 48);
      __builtin_amdgcn_sched_barrier(0);
      s0 = mfma(fa[0], qf[0], s0); s1 = mfma(fa[1], qf[0], s1); s0 = mfma(fa[2], qf[1], s0); s1 = mfma(fa[3], qf[1], s1);
      __builtin_amdgcn_sched_barrier(0);
      fa[0] = ld_frag(k0p + 64); fa[1] = ld_frag(k1p + 64); fa[2] = ld_frag(k0p + 80); fa[3] = ld_frag(k1p + 80);
      __builtin_amdgcn_sched_barrier(0);
      s0 = mfma(fb[0], qf[2], s0); s1 = mfma(fb[1], qf[2], s1); s0 = mfma(fb[2], qf[3], s0); s1 = mfma(fb[3], qf[3], s1);
      __builtin_amdgcn_sched_barrier(0);
      s0 = mfma(fa[0], qf[4], s0); s1 = mfma(fa[1], qf[4], s1); s0 = mfma(fa[2], qf[5], s0); s1 = mfma(fa[3], qf[5], s1);
    }
    if (!FAST) {
      float pmax = fmaxf(s0[0], s1[0]);
#pragma unroll
      for (int i = 1; i < 16; ++i) pmax = fmaxf(pmax, fmaxf(s0[i], s1[i]));
      pmax = max32(pmax);
      if (!__all(pmax <= 8.f)) {
        const float d = fmaxf(pmax, 0.f), al = __builtin_amdgcn_exp2f(-d);
        lsum *= al;
#pragma unroll
        for (int i = 0; i < 16; ++i) { negm[i] -= d; o[0][i] *= al; o[1][i] *= al; s0[i] -= d; s1[i] -= d; }
      }
    }
    f32x2 ps2 = {0.f, 0.f};
#pragma unroll
    for (int i = 0; i < 16; ++i) { s0[i] = __builtin_amdgcn_exp2f(s0[i]); s1[i] = __builtin_amdgcn_exp2f(s1[i]); ps2 += (f32x2){s0[i], s1[i]}; }
    lsum += ps2[0] + ps2[1];
#pragma unroll
    for (int n = 0; n < 2; ++n)
#pragma unroll
      for (int s2 = 0; s2 < 2; ++s2) {
        const f32x16& sv = n ? s1 : s0;
        u32x4 pk = {cvtpk(sv[8 * s2], sv[8 * s2 + 1]), cvtpk(sv[8 * s2 + 2], sv[8 * s2 + 3]), cvtpk(sv[8 * s2 + 4], sv[8 * s2 + 5]), cvtpk(sv[8 * s2 + 6], sv[8 * s2 + 7])};
        const bf16x8 pb = __builtin_bit_cast(bf16x8, pk);
#pragma unroll
        for (int dvt = 0; dvt < 2; ++dvt) {
          const bf16x8 va = ld_frag(Vs + (dvt * 32 + c) * AV_LD + (2 * n + s2) * 16 + hh * 8);
          o[dvt] = mfma(va, pb, o[dvt]);
        }
      }
    if (j + 1 < NT) swrite((j + 1) & 1);
    __syncthreads();
  }
  lsum = sum32(lsum);
  const float inv = 1.f / lsum;
  u16* dst = p->yb + (size_t)row * 512 + head * 64;
#pragma unroll
  for (int dvt = 0; dvt < 2; ++dvt)
#pragma unroll
    for (int g = 0; g < 4; ++g) st_bf4(dst + dvt * 32 + 8 * g + 4 * hh, o[dvt][4 * g] * inv, o[dvt][4 * g + 1] * inv, o[dvt][4 * g + 2] * inv, o[dvt][4 * g + 3] * inv);
}

DEVI float scan_sum(float v, int lane) {
#pragma unroll
  for (int o = 1; o < 64; o <<= 1) { const float t = shfl_up_f(v, o, lane); if (lane >= o) v += t; }
  return v;
}
DEVI float scan_max(float v, int lane) {
#pragma unroll
  for (int o = 1; o < 64; o <<= 1) { const float t = shfl_up_f(v, o, lane); if (lane >= o) v = fmaxf(v, t); }
  return v;
}
DEVI float ret_lg2(int head, int dir) { const int hx = dir ? 7 - head : head; return log2f(1.f - exp2f(-5.f - (float)hx)); }
DEVI int chain_step(int seg, int ck, int dir) { return dir ? (seg ? 1 - ck : 65 - ck) : (seg ? ck : 2 + ck); }

struct MlGate { float b0, b1, u0, u1, pm0, pm1, bl, umax; int i0, i1; };
DEVI MlGate ml_gates(PP p, int row0, int head, int dir, int lane) {
  MlGate g;
  g.i0 = dir ? 127 - lane : lane; g.i1 = dir ? 63 - lane : 64 + lane;
  const float* ga = p->gates + (size_t)(row0 + g.i0) * 32 + dir * 16 + head;
  const float* gb = p->gates + (size_t)(row0 + g.i1) * 32 + dir * 16 + head;
  const float ig0 = ga[0], fg0 = ga[8], ig1 = gb[0], fg1 = gb[8];
  const float lf0 = fminf(fg0, 0.f) - log1pf(__expf(-fabsf(fg0))), lf1 = fminf(fg1, 0.f) - log1pf(__expf(-fabsf(fg1)));
  g.b0 = scan_sum(lf0, lane); const float t0 = lane63(g.b0);
  g.b1 = scan_sum(lf1, lane) + t0; g.bl = lane63(g.b1);
  g.u0 = ig0 - g.b0; g.u1 = ig1 - g.b1;
  g.pm0 = scan_max(g.u0, lane); const float m0 = lane63(g.pm0);
  g.pm1 = fmaxf(scan_max(g.u1, lane), m0); g.umax = lane63(g.pm1);
  return g;
}

DEVI void conv16(PP p, int l, int rowbase, int L, int ti, int col0, float (&o)[16]) {
  const float* cw = p->conv_w + (size_t)l * 5 * 1024 + col0; const float* cb = p->conv_b + l * 1024 + col0;
#pragma unroll
  for (int k = 0; k < 16; k += 4) { const f32x4 b = *reinterpret_cast<const f32x4*>(cb + k); o[k] = b[0]; o[k + 1] = b[1]; o[k + 2] = b[2]; o[k + 3] = b[3]; }
#pragma unroll
  for (int j = 0; j < 5; ++j) {
    const int tj = ti + j - 2;
    if (tj >= 0 && tj < L) {
      const u16* src = p->P + (size_t)(rowbase + tj) * NINP + O_QK + col0;
      const u32x4 a = *reinterpret_cast<const u32x4*>(src), b = *reinterpret_cast<const u32x4*>(src + 8);
#pragma unroll
      for (int k = 0; k < 4; ++k) {
        const f32x4 w = *reinterpret_cast<const f32x4*>(cw + j * 1024 + 4 * k);
        const unsigned lo = k < 2 ? a[2 * k] : b[2 * k - 4], hi = k < 2 ? a[2 * k + 1] : b[2 * k - 3];
        o[4 * k] += w[0] * bflo(lo); o[4 * k + 1] += w[1] * bfhi(lo); o[4 * k + 2] += w[2] * bflo(hi); o[4 * k + 3] += w[3] * bfhi(hi);
      }
    }
  }
#pragma unroll
  for (int k = 0; k < 16; ++k) o[k] = siluf_(o[k]);
}
DEVI void ld16(const u16* src, float (&o)[16]) {
  const u32x4 a = *reinterpret_cast<const u32x4*>(src), b = *reinterpret_cast<const u32x4*>(src + 8);
#pragma unroll
  for (int k = 0; k < 4; ++k) { o[2 * k] = bflo(a[k]); o[2 * k + 1] = bfhi(a[k]); o[8 + 2 * k] = bflo(b[k]); o[8 + 2 * k + 1] = bfhi(b[k]); }
}
DEVI void rope16(float (&o)[16], const float* rope, int pos) {
#pragma unroll
  for (int f = 0; f < 8; ++f) { const float cs = rope[(pos * 8 + f) * 2], sn = rope[(pos * 8 + f) * 2 + 1];
    const float x1 = o[f], x2 = o[8 + f]; o[f] = x1 * cs - x2 * sn; o[8 + f] = x1 * sn + x2 * cs; }
}
DEVI void ret_qk16(PP p, int row, int col0, int part, bool latent, float scale, float (&o)[16]) {
  ld16(p->P + (size_t)row * NINP + col0 + part * 16, o);
  if (latent) { const int t = row & (SEQ - 1); rope16(o, p->rope, part ? (t & 63) : (t >> 6)); }
#pragma unroll
  for (int k = 0; k < 16; ++k) o[k] *= scale;
}

constexpr int VT_LD = 136;
DEVI void vt16(const u16* src, u16* dstcol) {
  const u32x4 a = *reinterpret_cast<const u32x4*>(src), b = *reinterpret_cast<const u32x4*>(src + 8);
#pragma unroll
  for (int k = 0; k < 4; ++k) {
    dstcol[(2 * k) * VT_LD] = (u16)(a[k] & 0xffffu); dstcol[(2 * k + 1) * VT_LD] = (u16)(a[k] >> 16);
    dstcol[(8 + 2 * k) * VT_LD] = (u16)(b[k] & 0xffffu); dstcol[(8 + 2 * k + 1) * VT_LD] = (u16)(b[k] >> 16);
  }
}
template <bool ML, int STAGE>
DEVI void scan_a_stage(PP p, int l, int b, int head, int seg, int ck, char* smem) {
  constexpr int DK = ML ? 64 : 32;
  u16* Vt = reinterpret_cast<u16*>(smem);
  u16* Kt = Vt + 64 * VT_LD;
  float* wg = reinterpret_cast<float*>(Kt + 2 * DK * VT_LD);
  const int tid = TIDX, lane = tid & 63, wid = tid >> 6, c = lane & 31, hh = lane >> 5;
  const int L = seg ? CTXL : SEQ, rowbase = seg ? TL + b * CTXL : b * SEQ, row0 = rowbase + ck * 128;
  const int chain0 = (b * 8 + head) * 2;
  if constexpr (STAGE == 0) {
  if (ML) {
    if (wid < 2) { const int dir = wid; const MlGate g = ml_gates(p, row0, head, dir, lane);
      wg[dir * 128 + g.i0] = __expf(g.u0 - g.umax); wg[dir * 128 + g.i1] = __expf(g.u1 - g.umax);
      if (lane == 0) { float* dm = p->dM + ((size_t)(chain0 + dir) * NCHUNK + chain_step(seg, ck, dir)) * 2; dm[0] = g.bl; dm[1] = g.bl + g.umax; } }
  } else {
    if (tid < 256) { const int dir = tid >> 7, i = tid & 127; wg[tid] = exp2f(ret_lg2(head, dir) * (float)(dir ? i : 127 - i)); }
  }
  }
  if constexpr (STAGE == 1) {
  {
    const int i = tid >> 2, part = tid & 3, pos = (i & ~15) | perm16(i & 15);
    vt16(p->P + (size_t)(row0 + i) * NINP + (ML ? O_V : O_RV) + head * 64 + part * 16, Vt + (part * 16) * VT_LD + pos);
    if (ML || part < 2) {
      float kv[16];
      if (ML) { conv16(p, l, rowbase, L, ck * 128 + i, 512 + head * 64 + part * 16, kv);
#pragma unroll
        for (int k = 0; k < 16; ++k) kv[k] *= 0.125f;
      } else ret_qk16(p, row0 + i, O_RK + head * 32, part, seg == 0, 0.17677669529663687f, kv);
      const float w0 = wg[i], w1 = wg[128 + i];
#pragma unroll
      for (int k = 0; k < 16; ++k) { const unsigned pk = cvtpk(kv[k] * w0, kv[k] * w1);
        Kt[(part * 16 + k) * VT_LD + pos] = (u16)(pk & 0xffffu); Kt[(DK + part * 16 + k) * VT_LD + pos] = (u16)(pk >> 16); }
    }
  }
  }
  if constexpr (STAGE == 2) {
  {
    const int dir = wid >> 2, vt = (wid >> 1) & 1, dt = wid & 1;
    const int j = chain_step(seg, ck, dir);
    if (ML || dt == 0) {
      f32x16 acc;
#pragma unroll
      for (int i = 0; i < 16; ++i) acc[i] = 0.f;
#pragma unroll
      for (int ks = 0; ks < 8; ++ks) acc = mfma(ld_frag(Vt + (vt * 32 + c) * VT_LD + ks * 16 + hh * 8), ld_frag(Kt + (dir * DK + dt * 32 + c) * VT_LD + ks * 16 + hh * 8), acc);
      float* dst = (ML ? p->dC : p->dR) + ((size_t)(chain0 + dir) * NCHUNK + j) * 64 * DK + dt * 32 + c;
#pragma unroll
      for (int i = 0; i < 16; ++i) dst[(size_t)(vt * 32 + crow(i, hh)) * DK] = acc[i];
    }
  }
  if (ML && tid < 128) {
    const int dir = tid >> 6, d = tid & 63;
    float s = 0.f;
#pragma unroll 4
    for (int i = 0; i < 16; ++i) { const u32x4 t = *reinterpret_cast<const u32x4*>(Kt + (dir * DK + d) * VT_LD + i * 8);
      s += bflo(t[0]) + bfhi(t[0]) + bflo(t[1]) + bfhi(t[1]) + bflo(t[2]) + bfhi(t[2]) + bflo(t[3]) + bfhi(t[3]); }
    p->dN[((size_t)(chain0 + dir) * NCHUNK + chain_step(seg, ck, dir)) * 64 + d] = s;
  }
  }
}
DEVI void scan_a_pair(PP p, int l, int b, int head, int seg, int ck, char* smem) {
  char* smB = smem + 56 * 1024;
  __syncthreads();
  scan_a_stage<true, 0>(p, l, b, head, seg, ck, smem); scan_a_stage<false, 0>(p, l, b, head, seg, ck, smB);
  __syncthreads();
  scan_a_stage<true, 1>(p, l, b, head, seg, ck, smem); scan_a_stage<false, 1>(p, l, b, head, seg, ck, smB);
  __syncthreads();
  scan_a_stage<true, 2>(p, l, b, head, seg, ck, smem); scan_a_stage<false, 2>(p, l, b, head, seg, ck, smB);
}
DEVI void carry_ml(PP p, int chain) {
  const int tid = TIDX;
  float C[8], n = 0.f, m = 0.f;
#pragma unroll
  for (int k = 0; k < 8; ++k) C[k] = 0.f;
  const size_t base0 = (size_t)chain * NCHUNK;
  f32x4 d0 = *reinterpret_cast<const f32x4*>(p->dC + base0 * 4096 + tid * 8), d1 = *reinterpret_cast<const f32x4*>(p->dC + base0 * 4096 + tid * 8 + 4);
  float bl = p->dM[base0 * 2], ml = p->dM[base0 * 2 + 1], dn = tid < 64 ? p->dN[base0 * 64 + tid] : 0.f;
  for (int j = 0; j < NCHUNK; ++j) {
    const size_t base = base0 + j;
    const size_t nb = base0 + (j + 1 < NCHUNK ? j + 1 : j);
    const f32x4 e0 = *reinterpret_cast<const f32x4*>(p->dC + nb * 4096 + tid * 8), e1 = *reinterpret_cast<const f32x4*>(p->dC + nb * 4096 + tid * 8 + 4);
    const float nbl = p->dM[nb * 2], nml = p->dM[nb * 2 + 1], ndn = tid < 64 ? p->dN[nb * 64 + tid] : 0.f;
    u32x4 cb = {cvtpk(C[0], C[1]), cvtpk(C[2], C[3]), cvtpk(C[4], C[5]), cvtpk(C[6], C[7])};
    *reinterpret_cast<u32x4*>(p->Cin + base * 4096 + tid * 8) = cb;
    if (tid < 64) p->nin[base * 64 + tid] = n;
    if (tid == 0) p->min_[base] = m;
    const float mn = fmaxf(bl + m, ml), a = __expf(bl + m - mn), bb = __expf(ml - mn);
#pragma unroll
    for (int k = 0; k < 4; ++k) { C[k] = a * C[k] + bb * d0[k]; C[4 + k] = a * C[4 + k] + bb * d1[k]; }
    n = a * n + bb * dn;
    m = mn;
    d0 = e0; d1 = e1; bl = nbl; ml = nml; dn = ndn;
  }
}
DEVI void carry_ret(PP p, int chain) {
  const int tid = TIDX, head = (chain >> 1) & 7, dir = chain & 1;
  const float cd = exp2f(128.f * ret_lg2(head, dir));
  float R[4] = {0.f, 0.f, 0.f, 0.f};
  const size_t base0 = (size_t)chain * NCHUNK;
  f32x4 d = *reinterpret_cast<const f32x4*>(p->dR + base0 * 2048 + tid * 4);
  for (int j = 0; j < NCHUNK; ++j) {
    const size_t base = base0 + j, nb = base0 + (j + 1 < NCHUNK ? j + 1 : j);
    const f32x4 e = *reinterpret_cast<const f32x4*>(p->dR + nb * 2048 + tid * 4);
    u32x2 rb = {cvtpk(R[0], R[1]), cvtpk(R[2], R[3])};
    *reinterpret_cast<u32x2*>(p->Rin + base * 2048 + tid * 4) = rb;
#pragma unroll
    for (int k = 0; k < 4; ++k) R[k] = cd * R[k] + d[k];
    d = e;
  }
}

template <bool ML>
DEVI void scan_c_unit(PP p, int l, int b, int head, int seg, int ck, char* smem) {
  constexpr int DK = ML ? 64 : 32, QLD = DK + 8;
  u16* Qs = reinterpret_cast<u16*>(smem);
  u16* Ks = Qs + 128 * QLD;
  u16* Vt = Ks + 128 * QLD;
  u16* Cs = Vt + 64 * VT_LD;
  float* fl = reinterpret_cast<float*>(Cs + 2 * 64 * QLD);
  float* alpha = fl;
  float* beta = fl + 256;
  float* inter = fl + 512;
  float* lowb = fl + 768;
  float* nv = fl + 1024;
  float* hbuf = fl + 1152;
  const int tid = TIDX, lane = tid & 63, wid = tid >> 6, c = lane & 31, hh = lane >> 5;
  const int L = seg ? CTXL : SEQ, rowbase = seg ? TL + b * CTXL : b * SEQ, row0 = rowbase + ck * 128;
  const int chain0 = (b * 8 + head) * 2;
  __syncthreads();
  if (ML && wid < 2) {
    const int dir = wid; const MlGate g = ml_gates(p, row0, head, dir, lane);
    const size_t base = (size_t)(chain0 + dir) * NCHUNK + chain_step(seg, ck, dir);
    const float m_in = p->min_[base];
    { const float a = g.b0 + m_in, mt = fmaxf(a, g.b0 + g.pm0); const int i = g.i0;
      alpha[dir * 128 + i] = (g.b0 - mt) * LOG2E; beta[dir * 128 + i] = g.u0 * LOG2E; inter[dir * 128 + i] = __expf(a - mt); lowb[dir * 128 + i] = __expf(-mt); }
    { const float a = g.b1 + m_in, mt = fmaxf(a, g.b1 + g.pm1); const int i = g.i1;
      alpha[dir * 128 + i] = (g.b1 - mt) * LOG2E; beta[dir * 128 + i] = g.u1 * LOG2E; inter[dir * 128 + i] = __expf(a - mt); lowb[dir * 128 + i] = __expf(-mt); }
    nv[dir * 64 + lane] = p->nin[base * 64 + lane];
  }
  {
    const int i = tid >> 2, part = tid & 3, pos = (i & ~15) | perm16(i & 15);
    float v[16];
    vt16(p->P + (size_t)(row0 + i) * NINP + (ML ? O_V : O_RV) + head * 64 + part * 16, Vt + (part * 16) * VT_LD + pos);
    if (!ML && tid < 256) { const int d_ = tid >> 7, si_ = tid & 127; beta[tid] = exp2f(ret_lg2(head, d_) * (float)(d_ ? si_ : -si_)); }
    if (ML) {
      conv16(p, l, rowbase, L, ck * 128 + i, head * 64 + part * 16, v);
      u32x4 a = {cvtpk(v[0], v[1]), cvtpk(v[2], v[3]), cvtpk(v[4], v[5]), cvtpk(v[6], v[7])}, bq = {cvtpk(v[8], v[9]), cvtpk(v[10], v[11]), cvtpk(v[12], v[13]), cvtpk(v[14], v[15])};
      *reinterpret_cast<u32x4*>(Qs + i * QLD + part * 16) = a; *reinterpret_cast<u32x4*>(Qs + i * QLD + part * 16 + 8) = bq;
      conv16(p, l, rowbase, L, ck * 128 + i, 512 + head * 64 + part * 16, v);
      u32x4 a2 = {cvtpk(v[0] * 0.125f, v[1] * 0.125f), cvtpk(v[2] * 0.125f, v[3] * 0.125f), cvtpk(v[4] * 0.125f, v[5] * 0.125f), cvtpk(v[6] * 0.125f, v[7] * 0.125f)};
      u32x4 b2 = {cvtpk(v[8] * 0.125f, v[9] * 0.125f), cvtpk(v[10] * 0.125f, v[11] * 0.125f), cvtpk(v[12] * 0.125f, v[13] * 0.125f), cvtpk(v[14] * 0.125f, v[15] * 0.125f)};
      *reinterpret_cast<u32x4*>(Ks + i * QLD + part * 16) = a2; *reinterpret_cast<u32x4*>(Ks + i * QLD + part * 16 + 8) = b2;
    } else {
      const bool isk = part >= 2; const int pp = part & 1;
      ret_qk16(p, row0 + i, (isk ? O_RK : O_RQ) + head * 32, pp, seg == 0, isk ? 0.17677669529663687f : 1.f, v);
      u32x4 a = {cvtpk(v[0], v[1]), cvtpk(v[2], v[3]), cvtpk(v[4], v[5]), cvtpk(v[6], v[7])}, bq = {cvtpk(v[8], v[9]), cvtpk(v[10], v[11]), cvtpk(v[12], v[13]), cvtpk(v[14], v[15])};
      u16* dst = (isk ? Ks : Qs) + i * QLD + pp * 16;
      *reinterpret_cast<u32x4*>(dst) = a; *reinterpret_cast<u32x4*>(dst + 8) = bq;
    }
    constexpr int CCH = 64 * DK / 8;
    for (int q = tid; q < 2 * CCH; q += NTHR) {
      const int dir = q / CCH, r = q % CCH, v_ = r / (DK / 8), kc = r % (DK / 8);
      const size_t base = (size_t)(chain0 + dir) * NCHUNK + chain_step(seg, ck, dir);
      const u16* src = (ML ? p->Cin : p->Rin) + base * 64 * DK + v_ * DK + kc * 8;
      *reinterpret_cast<u32x4*>(Cs + (dir * 64 + v_) * QLD + kc * 8) = *reinterpret_cast<const u32x4*>(src);
    }
  }
  __syncthreads();
  const int dir = wid >> 2, tq = wid & 3, t = tq * 32 + c;
  f32x16 num[2];
  {
    bf16x8 qf[DK / 16];
#pragma unroll
    for (int ks = 0; ks < DK / 16; ++ks) qf[ks] = ld_frag(Qs + t * QLD + ks * 16 + hh * 8);
#pragma unroll
    for (int i = 0; i < 16; ++i) { num[0][i] = 0.f; num[1][i] = 0.f; }
    float den = 0.f;
    const float lg2 = ML ? 0.f : ret_lg2(head, dir);
    const float al = ML ? alpha[dir * 128 + t] : 0.f;
    const int ss_lo = dir ? tq : 0, ss_hi = dir ? 3 : tq;
    for (int ss = ss_lo; ss <= ss_hi; ++ss) {
      f32x16 s;
#pragma unroll
      for (int i = 0; i < 16; ++i) s[i] = 0.f;
#pragma unroll
      for (int ks = 0; ks < DK / 16; ++ks) s = mfma(ld_frag(Ks + (ss * 32 + c) * QLD + ks * 16 + hh * 8), qf[ks], s);
#pragma unroll
      for (int g = 0; g < 4; ++g) {
        const int s0 = ss * 32 + 8 * g + 4 * hh;
        const f32x4 bt = *reinterpret_cast<const f32x4*>(beta + dir * 128 + s0);
#pragma unroll
        for (int j = 0; j < 4; ++j) {
          const int si = s0 + j;
          const float w = ML ? __builtin_amdgcn_exp2f(al + bt[j]) : bt[j];
          float pv = s[4 * g + j] * w;
          if (ss == tq) { const bool ok = dir ? (si >= t) : (si <= t); pv = ok ? pv : 0.f; }
          s[4 * g + j] = pv; den += pv;
        }
      }
#pragma unroll
      for (int s2 = 0; s2 < 2; ++s2) {
        u32x4 pk = {cvtpk(s[8 * s2], s[8 * s2 + 1]), cvtpk(s[8 * s2 + 2], s[8 * s2 + 3]), cvtpk(s[8 * s2 + 4], s[8 * s2 + 5]), cvtpk(s[8 * s2 + 6], s[8 * s2 + 7])};
        const bf16x8 pb = __builtin_bit_cast(bf16x8, pk);
#pragma unroll
        for (int vt = 0; vt < 2; ++vt) num[vt] = mfma(ld_frag(Vt + (vt * 32 + c) * VT_LD + ss * 32 + s2 * 16 + hh * 8), pb, num[vt]);
      }
    }
    f32x16 rq[2];
#pragma unroll
    for (int i = 0; i < 16; ++i) { rq[0][i] = 0.f; rq[1][i] = 0.f; }
#pragma unroll
    for (int vt = 0; vt < 2; ++vt)
#pragma unroll
      for (int ks = 0; ks < DK / 16; ++ks) rq[vt] = mfma(ld_frag(Cs + (dir * 64 + vt * 32 + c) * QLD + ks * 16 + hh * 8), qf[ks], rq[vt]);
    if (ML) {
      const float it = inter[dir * 128 + t];
      float nq = 0.f;
#pragma unroll
      for (int ks = 0; ks < DK / 16; ++ks) {
        const u32x4 qv = __builtin_bit_cast(u32x4, qf[ks]);
        const float* np_ = nv + dir * 64 + ks * 16 + hh * 8;
#pragma unroll
        for (int j = 0; j < 4; ++j) nq += bflo(qv[j]) * np_[2 * j] + bfhi(qv[j]) * np_[2 * j + 1];
      }
      nq = sum32(nq); den = sum32(den);
      const float dt = den + it * nq;
      const float inv = 1.f / fmaxf(fabsf(dt), lowb[dir * 128 + t]);
#pragma unroll
      for (int vt = 0; vt < 2; ++vt)
#pragma unroll
        for (int i = 0; i < 16; ++i) num[vt][i] = (num[vt][i] + it * rq[vt][i]) * inv;
    } else {
      const float xi = exp2f(lg2 * (float)(dir ? 128 - t : t + 1)), rowf = exp2f(lg2 * (float)(dir ? -t : t));
#pragma unroll
      for (int vt = 0; vt < 2; ++vt)
#pragma unroll
        for (int i = 0; i < 16; ++i) num[vt][i] = rowf * num[vt][i] + xi * rq[vt][i];
    }
    if (dir == 1) {
#pragma unroll
      for (int vt = 0; vt < 2; ++vt)
#pragma unroll
        for (int i = 0; i < 16; ++i) hbuf[t * 65 + vt * 32 + crow(i, hh)] = num[vt][i];
    }
  }
  __syncthreads();
  if (dir == 0) {
    float s1 = 0.f;
#pragma unroll
    for (int vt = 0; vt < 2; ++vt)
#pragma unroll
      for (int i = 0; i < 16; ++i) { num[vt][i] += hbuf[t * 65 + vt * 32 + crow(i, hh)]; s1 += num[vt][i]; }
    s1 = sum32(s1);
    const float mu = s1 * (1.f / 64.f);
    float s2 = 0.f;
#pragma unroll
    for (int vt = 0; vt < 2; ++vt)
#pragma unroll
      for (int i = 0; i < 16; ++i) { num[vt][i] -= mu; s2 += num[vt][i] * num[vt][i]; }
    s2 = sum32(s2);
    const float rstd = rsqrtf(s2 * (1.f / 64.f) + EPS);
    const int row = row0 + t;
    const float* nw_ = (ML ? p->ml_norm_w : p->ret_norm_w) + l * 512 + head * 64;
    const u16* gp = p->P + (size_t)row * NINP + (ML ? O_OG : O_RG) + head * 64;
    u16* dst = (ML ? p->ya : p->yc) + (size_t)row * 512 + head * 64;
#pragma unroll
    for (int vt = 0; vt < 2; ++vt)
#pragma unroll
      for (int g = 0; g < 4; ++g) {
        const int v0 = vt * 32 + 8 * g + 4 * hh;
        const f32x4 w = *reinterpret_cast<const f32x4*>(nw_ + v0);
        const u32x2 gt = *reinterpret_cast<const u32x2*>(gp + v0);
        const float gv[4] = {bflo(gt.x), bfhi(gt.x), bflo(gt.y), bfhi(gt.y)};
        float o[4];
#pragma unroll
        for (int j = 0; j < 4; ++j) { const float ga = ML ? sigmoidf_(gv[j]) : siluf_(gv[j]); o[j] = num[vt][4 * g + j] * rstd * w[j] * ga; }
        st_bf4(dst + v0, o[0], o[1], o[2], o[3]);
      }
  }
}

DEVI u16* zbuf(PP p, int br) { return br < 2 ? p->Q + (size_t)br * TT * DM : reinterpret_cast<u16*>(p->dC); }
DEVI void phase_merge(PP p, int l, char* smem) {
  fg::MergeZOrder S; S.init(GDIM, BIDX, (l == DEPTH - 1) ? TL / 256 : TT / 256);
  fg::Gemm g{p->ya, p->Wt_br + (size_t)l * 3 * 1024 * 512, 512, nullptr};
  fg::EpiZ E{zbuf(p, 0), zbuf(p, 2)};
  __syncthreads();
  fg::gemm_phase((LAS unsigned char*)(smem), g, S, E);
}

DEVI void phase_merge2(PP p, int l) {
  const int lane = TIDX & 63, gw = BIDX * 8 + (TIDX >> 6), nw = GDIM * 8;
  const int nrows = (l == DEPTH - 1) ? TL : TT;
  const u16* z0 = zbuf(p, 0); const u16* z1 = zbuf(p, 1); const u16* z2 = zbuf(p, 2);
  for (int r = gw; r < nrows; r += nw) {
#pragma unroll
    for (int i = 0; i < 2; ++i) {
      const int col = i * 512 + lane * 8;
      const size_t zo = (size_t)r * DM + col;
      const u16* lg = p->P + (size_t)r * NINP + O_LOG + col;
      const u32x4 a0 = *reinterpret_cast<const u32x4*>(z0 + zo), a1 = *reinterpret_cast<const u32x4*>(z1 + zo), a2 = *reinterpret_cast<const u32x4*>(z2 + zo);
      const u32x4 g0 = *reinterpret_cast<const u32x4*>(lg), g1 = *reinterpret_cast<const u32x4*>(lg + 1024), g2 = *reinterpret_cast<const u32x4*>(lg + 2048);
      u32x4 o;
#pragma unroll
      for (int j = 0; j < 4; ++j) {
        const float lo = sigmoidf_(bflo(g0[j])) * bflo(a0[j]) + sigmoidf_(bflo(g1[j])) * bflo(a1[j]) + sigmoidf_(bflo(g2[j])) * bflo(a2[j]);
        const float hi = sigmoidf_(bfhi(g0[j])) * bfhi(a0[j]) + sigmoidf_(bfhi(g1[j])) * bfhi(a1[j]) + sigmoidf_(bfhi(g2[j])) * bfhi(a2[j]);
        o[j] = cvtpk(lo, hi);
      }
      *reinterpret_cast<u32x4*>(p->hb + zo) = o;
    }
  }
}

DEVI void phase_wout(PP p, int l, char* smem) {
  {
    fg::StaticOrder S; S.init(TL / 256, DM / 256, GDIM, BIDX);
    fg::Gemm g{p->hb, p->Wt_out + (size_t)l * DM * DM, DM, nullptr};
    fg::EpiWout E{l == 0 ? p->x : p->xw, p->xw, modp(p, l, 0, 2), modp(p, l, 1, 2)};
    __syncthreads();
    fg::gemm_phase((LAS unsigned char*)(smem), g, S, E);
  }
  if (l == DEPTH - 1) return;
  u16* sm = reinterpret_cast<u16*>(smem);
  const int lane = TIDX & 63, wid = TIDX >> 6, c = lane & 31, hh = lane >> 5, wm = wid >> 2, wn = wid & 3;
  for (int u = (BIDX + 128) % GDIM; u < 64; u += GDIM) {
    const int r0 = TL + (u >> 3) * 64, nt = u & 7;
    f32x16 acc[1][1]; zero_acc(acc);
    XRowLin xr{p->hb + (size_t)r0 * DM, (size_t)DM};
    __syncthreads();
    GemmS::kloop(acc, xr, p->Wt_out + (size_t)l * DM * DM + (size_t)nt * 128 * DM, DM, DM, sm);
    const int row = r0 + wm * 32 + c;
    const float* g1 = modp(p, l, 2, 2);
    const float* xo = xin_row(p, l, row);
#pragma unroll
    for (int g = 0; g < 4; ++g) { const int feat = nt * 128 + wn * 32 + 8 * g + 4 * hh;
      const f32x4 gv = *reinterpret_cast<const f32x4*>(g1 + feat), xv = *reinterpret_cast<const f32x4*>(xo + feat);
      const f32x4 o = {xv[0] + gv[0] * acc[0][0][4 * g], xv[1] + gv[1] * acc[0][0][4 * g + 1], xv[2] + gv[2] * acc[0][0][4 * g + 2], xv[3] + gv[3] * acc[0][0][4 * g + 3]};
      *reinterpret_cast<f32x4*>(p->xw + (size_t)row * DM + feat) = o; }
  }
}

DEVI void phase_norm2(PP p, int l, char* smem) {
  float* rs = reinterpret_cast<float*>(smem);
  const int tid = TIDX, lane = tid & 63, gw = BIDX * 8 + (tid >> 6), nw = GDIM * 8;
  __syncthreads();
  for (int i = tid; i < DM * NE; i += NTHR) rs[(i >> 4) * 17 + (i & 15)] = p->router_w[(size_t)l * DM * NE + i];
  __syncthreads();
  const int nrows = (l == DEPTH - 1) ? TL : TT;
  for (int r = gw; r < nrows; r += nw) {
    const int cond = row_cond(r);
    const float* xr = p->xw + (size_t)r * DM;
    float v[16]; float ss = 0.f;
#pragma unroll
    for (int i = 0; i < 16; ++i) { v[i] = xr[lane + 64 * i]; ss += v[i] * v[i]; }
    ss = wave_sum(ss);
    const float rstd = rsqrtf(ss * (1.f / DM) + EPS);
    const float* nw_ = p->norm2_w + l * DM; const float* sc = modp(p, l, cond, 4); const float* sh = modp(p, l, cond, 3);
    f32x2 lg2[8];
#pragma unroll
    for (int e = 0; e < 8; ++e) lg2[e] = (f32x2){0.f, 0.f};
#pragma unroll
    for (int i = 0; i < 16; ++i) {
      const int k = lane + 64 * i;
      const float h = v[i] * rstd * nw_[k] * (1.f + sc[k]) + sh[k];
      p->hb[(size_t)r * DM + k] = f2bf(h);
      const f32x2 h2 = {h, h};
#pragma unroll
      for (int e = 0; e < 8; ++e) lg2[e] += h2 * (f32x2){rs[k * 17 + 2 * e], rs[k * 17 + 2 * e + 1]};
    }
    float lg[16];
#pragma unroll
    for (int e = 0; e < 8; ++e) { lg[2 * e] = lg2[e][0]; lg[2 * e + 1] = lg2[e][1]; }
    float mx = -1e30f;
#pragma unroll
    for (int e = 0; e < 16; ++e) { lg[e] = wave_sum(lg[e]); mx = fmaxf(mx, lg[e]); }
    float sum = 0.f;
#pragma unroll
    for (int e = 0; e < 16; ++e) { lg[e] = __expf(lg[e] - mx); sum += lg[e]; }
    const float inv = 1.f / sum;
    float mine = 0.f;
#pragma unroll
    for (int e = 0; e < 16; ++e) mine = (lane == e) ? lg[e] * inv : mine;
    if (lane < 16) {
      if (r < TL) p->aff[((size_t)(r >> 13) * NE + lane) * SEQ + (r & (SEQ - 1))] = mine;
      else { const int rc = r - TL; p->aff[(size_t)NB * NE * SEQ + ((size_t)(rc >> 8) * NE + lane) * CTXL + (rc & (CTXL - 1))] = mine; }
    }
  }
}

DEVI void topk_problem(PP p, int l, int prob, char* smem) {
  unsigned* vals = reinterpret_cast<unsigned*>(smem);
  unsigned* hist = vals + 8192;
  unsigned* sc = hist + 256;
  const int tid = TIDX, lane = tid & 63, wid = tid >> 6;
  const bool lat = prob < 32; const int pb = lat ? prob : prob - 32, b = pb >> 4, e = pb & 15;
  const int n = lat ? SEQ : CTXL, k = lat ? 1024 : 32;
  const float* src = p->aff + (lat ? ((size_t)b * NE + e) * SEQ : (size_t)NB * NE * SEQ + ((size_t)b * NE + e) * CTXL);
  const int sbase = lat ? b * 1024 : 2048 + b * 32, rowbase = lat ? b * SEQ : TL + b * CTXL;
  __syncthreads();
  for (int i = tid; i < n; i += NTHR) vals[i] = __float_as_uint(src[i]);
  unsigned prefix = 0, mask = 0, kk = (unsigned)k;
  for (int pass = 3; pass >= 0; --pass) {
    const int shift = pass * 8;
    if (tid < 256) hist[tid] = 0;
    __syncthreads();
    for (int i = tid; i < n; i += NTHR) { const unsigned v = vals[i]; if ((v & mask) == prefix) atomicAdd(&hist[(v >> shift) & 255u], 1u); }
    __syncthreads();
    if (wid == 0) {
      const int b0 = 255 - 4 * lane;
      const unsigned h0 = hist[b0], h1 = hist[b0 - 1], h2 = hist[b0 - 2], h3 = hist[b0 - 3];
      unsigned incl = h0 + h1 + h2 + h3;
#pragma unroll
      for (int o = 1; o < 64; o <<= 1) { const unsigned t = shfl_up_u(incl, o, lane); if (lane >= o) incl += t; }
      const unsigned excl = incl - (h0 + h1 + h2 + h3);
      if (excl < kk && incl >= kk) {
        unsigned cum = excl; int d = b0;
        if (cum + h0 < kk) { cum += h0; d = b0 - 1; if (cum + h1 < kk) { cum += h1; d = b0 - 2; if (cum + h2 < kk) { cum += h2; d = b0 - 3; } } }
        sc[0] = prefix | ((unsigned)d << shift); sc[1] = kk - cum;
      }
    }
    __syncthreads();
    prefix = sc[0]; kk = sc[1]; mask |= 0xffu << shift;
    __syncthreads();
  }
  const unsigned thr = prefix, need_eq = kk;
  const int per = lat ? 16 : 1, i0 = tid * per;
  unsigned cnt = 0;
  if (i0 < n) for (int j = 0; j < per; ++j) { const unsigned v = vals[i0 + j]; cnt += (v > thr ? 1u : 0u) + (v == thr ? 65536u : 0u); }
  unsigned incl = cnt;
#pragma unroll
  for (int o = 1; o < 64; o <<= 1) { const unsigned t = shfl_up_u(incl, o, lane); if (lane >= o) incl += t; }
  if (lane == 63) sc[8 + wid] = incl;
  __syncthreads();
  unsigned woff = 0;
  for (int w = 0; w < wid; ++w) woff += sc[8 + w];
  unsigned run = woff + incl - cnt;
  if (i0 < n) for (int j = 0; j < per; ++j) {
    const int i = i0 + j; const unsigned v = vals[i];
    const unsigned gtb = run & 0xffffu, eqb = run >> 16;
    const bool isgt = v > thr, iseq = v == thr, selq = isgt || (iseq && eqb < need_eq);
    const int slot = sbase + (int)(gtb + (eqb < need_eq ? eqb : need_eq));
    const int row = rowbase + i;
    if (selq) { p->ridx[e * ESLOTS + slot] = row; p->rgate[e * ESLOTS + slot] = __uint_as_float(v); }
    p->sel[(size_t)row * 16 + e] = selq ? slot : -1;
    run += (isgt ? 1u : 0u) + (iseq ? 65536u : 0u);
  }
  if (lat && b == 0) { const int lo = (l == DEPTH - 1) ? 2048 : 2112; for (int s = lo + tid; s < ESLOTS; s += NTHR) { p->ridx[e * ESLOTS + s] = 0; p->rgate[e * ESLOTS + s] = 0.f; } }
}

DEVI void phase_gather(PP p) {
  const int lane = TIDX & 63, gw = BIDX * 8 + (TIDX >> 6), nw = GDIM * 8;
  for (int r = gw; r < NE * 2048; r += nw) {
    const int e = r >> 11, slot = r & 2047;
    const u16* src = p->hb + (size_t)p->ridx[e * ESLOTS + slot] * DM;
    u16* dst = p->Xg + ((size_t)e * ESLOTS + slot) * DM;
    const u32x4 a = *reinterpret_cast<const u32x4*>(src + lane * 8), b2 = *reinterpret_cast<const u32x4*>(src + 512 + lane * 8);
    *reinterpret_cast<u32x4*>(dst + lane * 8) = a; *reinterpret_cast<u32x4*>(dst + 512 + lane * 8) = b2;
  }
}
DEVI void phase_exp1(PP p, int l, char* smem) {
  {
    fg::ExpertOrder S; S.init(8, 8, ESLOTS / 256, GDIM, BIDX);
    fg::Gemm g{p->hb, p->We13 + (size_t)l * NE * 2048 * DM, DM, p->ridx};
    fg::EpiSwiglu E{p->hid};
    __syncthreads();
    fg::gemm_phase<fg::EpiSwiglu, fg::ExpertOrder, true>((LAS unsigned char*)(smem), g, S, E);
  }
  if (l == DEPTH - 1) return;
  u16* sm = reinterpret_cast<u16*>(smem);
  const int lane = TIDX & 63, wid = TIDX >> 6, c = lane & 31, hh = lane >> 5, wm = wid >> 2, wn = wid & 3;
  for (int u = BIDX; u < NE * 8; u += GDIM) {
    const int e = u >> 3, jf = u & 7;
    f32x16 a1[1][1], a3[1][1]; zero_acc(a1); zero_acc(a3);
    XRowIdx xr{p->hb, p->ridx + e * ESLOTS + 2048};
    const u16* wb = p->We13 + ((size_t)(l * NE + e) * 2048 + jf * 256) * DM;
    __syncthreads();
    GemmS::kloop(a1, xr, wb, DM, DM, sm);
    GemmS::kloop(a3, xr, wb + (size_t)128 * DM, DM, DM, sm);
    const int slot = 2048 + wm * 32 + c;
    u16* dst = p->hid + ((size_t)e * ESLOTS + slot) * FF + jf * 128 + wn * 32;
#pragma unroll
    for (int g = 0; g < 4; ++g) {
      float o[4];
#pragma unroll
      for (int j = 0; j < 4; ++j) o[j] = siluf_(a1[0][0][4 * g + j]) * a3[0][0][4 * g + j];
      st_bf4(dst + 8 * g + 4 * hh, o[0], o[1], o[2], o[3]);
    }
  }
}
DEVI void phase_exp2(PP p, int l, char* smem) {
  {
    fg::ExpertOrder S; S.init(8, 4, ESLOTS / 256, GDIM, BIDX);
    fg::Gemm g{p->hid, p->We2 + (size_t)l * NE * DM * FF, FF, nullptr};
    fg::EpiY E{p->Y, p->rgate};
    __syncthreads();
    fg::gemm_phase((LAS unsigned char*)(smem), g, S, E);
  }
  if (l == DEPTH - 1) return;
  u16* sm = reinterpret_cast<u16*>(smem);
  const int lane = TIDX & 63, wid = TIDX >> 6, c = lane & 31, hh = lane >> 5, wm = wid >> 2, wn = wid & 3;
  for (int u = BIDX; u < NE * 8; u += GDIM) {
    const int e = u >> 3, nt = u & 7;
    f32x16 acc[1][1]; zero_acc(acc);
    XRowLin xr{p->hid + ((size_t)e * ESLOTS + 2048) * FF, (size_t)FF};
    __syncthreads();
    GemmS::kloop(acc, xr, p->We2 + ((size_t)(l * NE + e) * DM + nt * 128) * FF, FF, FF, sm);
    const int slot = 2048 + wm * 32 + c;
    const float gt = p->rgate[e * ESLOTS + slot];
    u16* dst = p->Y + ((size_t)e * ESLOTS + slot) * DM + nt * 128 + wn * 32;
#pragma unroll
    for (int g = 0; g < 4; ++g) st_bf4(dst + 8 * g + 4 * hh, gt * acc[0][0][4 * g], gt * acc[0][0][4 * g + 1], gt * acc[0][0][4 * g + 2], gt * acc[0][0][4 * g + 3]);
  }
}

DEVI void phase_proj_scan_a(PP p, int l, char* smem, unsigned* ctr) {
  u16* sm = reinterpret_cast<u16*>(smem);
  int* slot = reinterpret_cast<int*>(smem + LDS_BYTES - 128);
  constexpr int NQ = (TT / 256) * 8, NSC = NB * 8 * NCHUNK;
  const int total = 2 * NQ + NSC;
  int nxt = (TIDX == 0) ? (int)atomicAdd(ctr, 1u) : 0;
  for (;;) {
    __syncthreads();
    if (TIDX == 0) *slot = nxt;
    __syncthreads();
    const int u = *slot;
    if (u >= total) break;
    if (TIDX == 0) nxt = (int)atomicAdd(ctr, 1u);
    if (u < NQ) mlakv_unit(p, l, u >> 3, u & 7, sm);
    else if (u < 2 * NQ) mlaq_unit(p, l, (u - NQ) >> 3, (u - NQ) & 7, sm);
    else {
      const int v = u - 2 * NQ;
      const int bh = v / NCHUNK, cc = v % NCHUNK, seg = cc < 2 ? 1 : 0, ck = seg ? cc : cc - 2;
      scan_a_pair(p, l, bh >> 3, bh & 7, seg, ck, smem);
    }
  }
}
DEVI void scan_c_item(PP p, int l, int u, char* smem) {
  const int per = (l == DEPTH - 1) ? 64 : NCHUNK;
  const int NSC = NB * 8 * per;
  int v = u; const bool ml = v < NSC; if (!ml) v -= NSC;
  const int bh = v / per, cc = v % per;
  int seg, ck; if (per == 64) { seg = 0; ck = cc; } else { seg = cc < 2 ? 1 : 0; ck = seg ? cc : cc - 2; }
  if (ml) scan_c_unit<true>(p, l, bh >> 3, bh & 7, seg, ck, smem); else scan_c_unit<false>(p, l, bh >> 3, bh & 7, seg, ck, smem);
}
DEVI void phase_attn_carry(PP p, int l, char* smem, unsigned* ctr) {
  u16* sm = reinterpret_cast<u16*>(smem);
  int* slot = reinterpret_cast<int*>(smem + LDS_BYTES - 128);
  const bool lastl = (l == DEPTH - 1);
  const bool fast = __builtin_amdgcn_readfirstlane(__float_as_int(p->attb[l])) < __float_as_int(60.f);
  const int x0 = (int)(xb_xcc_id() & 7u);
  for (int sx = 0; sx < 8; ++sx) {
    const int x = (x0 + sx) & 7;
    const int natt = lastl ? 64 : 66;
    const int total = 8 + natt;
    int nxt = (TIDX == 0) ? (int)atomicAdd(ctr + x * 8, 1u) : 0;
    for (;;) {
      __syncthreads();
      if (TIDX == 0) *slot = nxt;
      __syncthreads();
      const int u = *slot;
      if (u >= total) break;
      if (TIDX == 0) nxt = (int)atomicAdd(ctr + x * 8, 1u);
      if (u < 8) {
        if (u < 4) carry_ml(p, u * 8 + x); else carry_ret(p, (u - 4) * 8 + x);
        asm volatile("s_waitcnt vmcnt(0)" ::: "memory");
        __syncthreads();
        if (TIDX == 0) { __builtin_amdgcn_fence(__ATOMIC_RELEASE, "agent"); asm volatile("s_waitcnt vmcnt(0)" ::: "memory");
          __hip_atomic_fetch_add(ctr + 4, 1u, __ATOMIC_RELAXED, __HIP_MEMORY_SCOPE_AGENT); }
        continue;
      }
      const int att = u - 8;
      {
        int bh, q0, nk;
        if (att < 64) { bh = (att < 32) ? x : x + 8; q0 = (bh >> 3) * SEQ + (att & 31) * 256; nk = KEYS; }
        else { bh = (att == 64) ? x : x + 8; q0 = TL + (bh >> 3) * CTXL; nk = CTXL; }
        if (fast) attn_unit<true>(p, bh >> 3, bh & 7, q0, nk, sm); else attn_unit<false>(p, bh >> 3, bh & 7, q0, nk, sm);
      }
    }
  }
  __syncthreads();
  if (TIDX == 0) {
    unsigned sp = 0;
    while (__hip_atomic_load(ctr + 4, __ATOMIC_RELAXED, __HIP_MEMORY_SCOPE_AGENT) < 64u) { __builtin_amdgcn_s_sleep(2); if (++sp > (1u << 22)) break; }
    __builtin_amdgcn_fence(__ATOMIC_ACQUIRE, "agent");
    asm volatile("s_waitcnt vmcnt(0)" ::: "memory");
  }
  __syncthreads();
  {
    const int nsc = 2 * NB * 8 * (lastl ? 64 : NCHUNK);
    const int total = lastl ? nsc : ((nsc + 8) / 9) * 11;
    int nxt = (TIDX == 0) ? (int)atomicAdd(ctr + 5, 1u) : 0;
    for (;;) {
      __syncthreads();
      if (TIDX == 0) *slot = nxt;
      __syncthreads();
      const int u = *slot;
      if (u >= total) break;
      if (TIDX == 0) nxt = (int)atomicAdd(ctr + 5, 1u);
      if (lastl) { scan_c_item(p, l, u, smem); continue; }
      const int g = u / 11, r = u - g * 11;
      if (r < 9) { if (g * 9 + r < nsc) scan_c_item(p, l, g * 9 + r, smem); }
      else {
        const int j = g * 2 + (r - 9);
        if (j < CVT_JOBS) cvt_bundle(p, l + 1, j);
      }
    }
  }
}

DEVI void phase_topk(PP p, int l, char* smem) {
  const int nprob = (l == DEPTH - 1) ? 32 : 64;
  for (int u = BIDX; u < nprob; u += GDIM) topk_problem(p, l, u, smem);
}

constexpr int STEPS_PER_LAYER = 11, NSTEPS = 1 + DEPTH * STEPS_PER_LAYER + 1;
__global__ void __launch_bounds__(NTHR, 2) mega(Params p_by_value, int s_lo, int s_hi) {
  extern __shared__ __attribute__((aligned(16))) char lds[];
  PP p = (PP)__builtin_amdgcn_kernarg_segment_ptr();
  if (TIDX == 0) { reinterpret_cast<unsigned*>(lds)[0] = 0u; reinterpret_cast<unsigned*>(lds)[1] = 0u; reinterpret_cast<unsigned*>(lds)[2] = 0u; reinterpret_cast<unsigned*>(lds)[3] = 0u; }
  __syncthreads();
  XcdBarrier bar = xcd_barrier_post(p->bar + (size_t)s_lo * XCD_BAR_WORDS, (volatile LAS unsigned*)lds);
  char* smem = lds + 64;
  int s = 0;
#define STEP(...) do { if (s >= s_lo && s < s_hi) { asm volatile("" : "+s"(p)); __VA_ARGS__; if (s + 1 < s_hi) xcd_barrier(bar); } ++s; } while (0)
#ifndef PROBE_MASK
#define PROBE_MASK 0
#endif
#define DUP(bit, ...) do { __VA_ARGS__; if (PROBE_MASK & (1 << (bit))) { __syncthreads(); __VA_ARGS__; } } while (0)
  STEP(DUP(0, phase_prologue(p, smem)));
#pragma unroll 1
  for (int l = 0; l < DEPTH; ++l) {
    STEP({ if (l == 0) phase_norm1<false, false>(p, l); else phase_norm1<true, false>(p, l); });
    STEP(DUP(1, phase_inproj(p, l, smem)));
    STEP(phase_proj_scan_a(p, l, smem, p->ctr + 64 * l + 6));
    STEP(phase_attn_carry(p, l, smem, p->ctr + 64 * l));
    STEP(phase_merge(p, l, smem));
    STEP(phase_merge2(p, l));
    STEP(phase_wout(p, l, smem));
    STEP(DUP(6, phase_norm2(p, l, smem)));
    STEP(DUP(7, phase_topk(p, l, smem)));
    STEP(DUP(8, phase_exp1(p, l, smem)));
    STEP(DUP(9, phase_exp2(p, l, smem)));
  }
  STEP((phase_norm1<true, true>(p, DEPTH)));
#undef STEP
}

#ifndef MK_MULTI
#define MK_MULTI 0
#endif
extern "C" void kernel_launch(void* const* d_in, const int* in_sizes, int n_in, void* d_out, int out_size, void* d_ws, size_t ws_size, hipStream_t stream) {
  static int grid = 0;
  if (grid == 0) {
    int dev = 0, cus = 0, per_cu = 0;
    (void)hipGetDevice(&dev); (void)hipDeviceGetAttribute(&cus, hipDeviceAttributeMultiprocessorCount, dev);
    (void)hipFuncSetAttribute((const void*)mega, hipFuncAttributeMaxDynamicSharedMemorySize, LDS_BYTES);
    (void)hipOccupancyMaxActiveBlocksPerMultiprocessor(&per_cu, (const void*)mega, NTHR, LDS_BYTES);
    (void)hipGetLastError();
    grid = cus > 0 ? cus : 256;
    if (per_cu < 1) fprintf(stderr, "kernel_launch: occupancy query reports %d blocks per CU\n", per_cu);
  }
  Params p{};
  const float** in = reinterpret_cast<const float**>(&p);
  for (int i = 0; i < 26; ++i) in[i] = (const float*)d_in[i];
  p.out = (float*)d_out;
  char* w = (char*)d_ws; size_t off = 0;
  auto take = [&](size_t bytes) { char* r = w + off; off += (bytes + 255) & ~(size_t)255; return r; };
  const size_t ctl_bytes = (size_t)(NSTEPS + 1) * XCD_BAR_WORDS * 4 + 4096;
  p.bar = (unsigned*)take(ctl_bytes); p.ctr = p.bar + (size_t)(NSTEPS + 1) * XCD_BAR_WORDS;
  p.Wt_in = (u16*)take((size_t)DEPTH * NINP * DM * 2 + 65536);
  p.Wt_qb = (u16*)take((size_t)DEPTH * 768 * 384 * 2);
  p.Wt_kvb = (u16*)take((size_t)DEPTH * 1024 * 256 * 2);
  p.Wt_br = (u16*)take((size_t)DEPTH * 3 * 1024 * 512 * 2);
  p.Wt_out = (u16*)take((size_t)DEPTH * DM * DM * 2);
  p.We13 = (u16*)take((size_t)DEPTH * NE * 2048 * DM * 2);
  p.We2 = (u16*)take((size_t)DEPTH * NE * DM * FF * 2);
  p.mod = (float*)take((size_t)DEPTH * 3 * 6144 * 4);
  p.rope = (float*)take(128 * 16 * 4); p.attb = (float*)take(256);
  p.xw = (float*)take((size_t)TT * DM * 4);
  p.gates = (float*)take((size_t)TT * 32 * 4);
  p.hb = (u16*)take((size_t)TT * DM * 2);
  p.P = (u16*)take((size_t)TT * NINP * 2);
  p.Q = (u16*)take((size_t)TT * 768 * 2);
  p.K = (u16*)take((size_t)NB * KEYS * 768 * 2);
  p.Vt = (u16*)take((size_t)NB * 8 * 64 * KEYS * 2);
  p.ya = (u16*)take((size_t)TT * 512 * 2); p.yb = (u16*)take((size_t)TT * 512 * 2); p.yc = (u16*)take((size_t)TT * 512 * 2);
  p.dC = (float*)take((size_t)32 * NCHUNK * 4096 * 4); p.dN = (float*)take((size_t)32 * NCHUNK * 64 * 4); p.dM = (float*)take((size_t)32 * NCHUNK * 2 * 4);
  p.nin = (float*)take((size_t)32 * NCHUNK * 64 * 4); p.min_ = (float*)take((size_t)32 * NCHUNK * 4); p.dR = (float*)take((size_t)32 * NCHUNK * 2048 * 4);
  p.Cin = (u16*)take((size_t)32 * NCHUNK * 4096 * 2); p.Rin = (u16*)take((size_t)32 * NCHUNK * 2048 * 2);
  p.aff = (float*)take((size_t)TT * NE * 4); p.rgate = (float*)take((size_t)NE * ESLOTS * 4);
  p.ridx = (int*)take((size_t)NE * ESLOTS * 4); p.sel = (int*)take((size_t)TT * NE * 4);
  p.hid = p.P; p.Y = p.P + (size_t)NE * ESLOTS * FF; p.Xg = p.Y + (size_t)NE * ESLOTS * DM;
  if (off > ws_size || n_in != 26 || out_size != TL * DM) { fprintf(stderr, "kernel_launch: workspace %zu needed, %zu given (n_in %d out %d)\n", off, ws_size, n_in, out_size); return; }
  (void)hipMemsetAsync(p.bar, 0, ctl_bytes, stream);
#if MK_MULTI
  for (int s = 0; s < NSTEPS; ++s) hipLaunchKernelGGL(mega, dim3(grid), dim3(NTHR), LDS_BYTES, stream, p, s, s + 1);
#else
  hipLaunchKernelGGL(mega, dim3(grid), dim3(NTHR), LDS_BYTES, stream, p, 0, NSTEPS);
#endif
}
```

```cpp
#include <hip/hip_runtime.h>
#include <stdint.h>
#include <stdio.h>

#define DEVI __device__ __forceinline__
typedef unsigned short u16;
typedef short bf16x8 __attribute__((ext_vector_type(8)));
typedef float f32x16 __attribute__((ext_vector_type(16)));
typedef float f32x4 __attribute__((ext_vector_type(4)));
typedef float f32x2 __attribute__((ext_vector_type(2)));
typedef unsigned u32x4 __attribute__((ext_vector_type(4)));
typedef unsigned u32x2 __attribute__((ext_vector_type(2)));

constexpr int DM = 1024, NB = 2, SEQ = 8192, CTXL = 256, DEPTH = 4;
constexpr int TL = NB * SEQ, TC = NB * CTXL, TT = TL + TC;
constexpr int NIN = 7360, NINP = 7424;
constexpr int O_QK = 0, O_V = 1024, O_OG = 1536, O_GATES = 2048, O_QLAT = 2080, O_KVLAT = 2464, O_KROPE = 2720,
              O_RQ = 2752, O_RK = 3008, O_RV = 3264, O_RG = 3776, O_LOG = 4288;
constexpr int NE = 16, FF = 1024, KEYS = CTXL + SEQ;
constexpr int ESLOTS = 2304;
constexpr int NCHUNK = 66;
constexpr float EPS = 1e-6f, LOG2E = 1.4426950408889634f;
constexpr int NTHR = 512;
constexpr int LDS_BYTES = 136 * 1024;

DEVI unsigned cvtpk(float lo, float hi) { unsigned r; asm("v_cvt_pk_bf16_f32 %0, %1, %2" : "=v"(r) : "v"(lo), "v"(hi)); return r; }
DEVI float bf2f(u16 v) { return __uint_as_float(((unsigned)v) << 16); }
DEVI float bflo(unsigned v) { return __uint_as_float(v << 16); }
DEVI float bfhi(unsigned v) { return __uint_as_float(v & 0xffff0000u); }
DEVI u16 f2bf(float f) { return (u16)(cvtpk(f, 0.f) & 0xffffu); }
DEVI int crow(int i, int h) { return (i & 3) + 8 * (i >> 2) + 4 * h; }
DEVI float sum32(float v) { const auto r = __builtin_amdgcn_permlane32_swap(__float_as_uint(v), __float_as_uint(v), false, false); return __uint_as_float(r[0]) + __uint_as_float(r[1]); }
DEVI float max32(float v) { const auto r = __builtin_amdgcn_permlane32_swap(__float_as_uint(v), __float_as_uint(v), false, false); return fmaxf(__uint_as_float(r[0]), __uint_as_float(r[1])); }
#define DPP_F(v, ctrl) __uint_as_float((unsigned)__builtin_amdgcn_mov_dpp((int)__float_as_uint(v), (ctrl), 0xf, 0xf, true))
DEVI float wave_sum(float v) {
  v += DPP_F(v, 0xB1);
  v += DPP_F(v, 0x4E);
  v += DPP_F(v, 0x141);
  v += DPP_F(v, 0x140);
  { const auto r = __builtin_amdgcn_permlane16_swap(__float_as_uint(v), __float_as_uint(v), false, false); v = __uint_as_float(r[0]) + __uint_as_float(r[1]); }
  return sum32(v);
}
DEVI float shfl_up_f(float v, int o, int lane) { return __uint_as_float((unsigned)__builtin_amdgcn_ds_bpermute((lane - o) << 2, (int)__float_as_uint(v))); }
DEVI unsigned shfl_up_u(unsigned v, int o, int lane) { return (unsigned)__builtin_amdgcn_ds_bpermute((lane - o) << 2, (int)v); }
DEVI float lane63(float v) { return __uint_as_float((unsigned)__builtin_amdgcn_readlane((int)__float_as_uint(v), 63)); }
DEVI float sigmoidf_(float x) { return __builtin_amdgcn_rcpf(1.f + __expf(-x)); }
DEVI float siluf_(float x) { return x * __builtin_amdgcn_rcpf(1.f + __expf(-x)); }
DEVI f32x16 mfma(bf16x8 a, bf16x8 b, f32x16 c) { return __builtin_amdgcn_mfma_f32_32x32x16_bf16(a, b, c, 0, 0, 0); }
DEVI bf16x8 ld_frag(const u16* p) { return *reinterpret_cast<const bf16x8*>(p); }
DEVI float sumsq8_(u32x4 t) { float s_ = 0.f;
#pragma unroll
  for (int j = 0; j < 4; ++j) { const float a = bflo(t[j]), b = bfhi(t[j]); s_ += a * a + b * b; }
  return s_; }
DEVI int perm16(int i) { return (i & ~12) | ((i & 4) << 1) | ((i & 8) >> 1); }

#define XB_TMO      128
#define XB_XCNT(j)  (256  + 64 * (j))
#define XB_XSUB(j)  (1280 + 64 * (j))
#define XB_XGEN(j)  (2304 + 64 * (j))
#define XB_TOP      3328
#define XB_TOPGEN   3392
#define XCD_BAR_WORDS 3456
#define XB_SPIN_CAP (1u << 20)
#define LAS __attribute__((address_space(3)))
DEVI unsigned xb_ld(unsigned* p)              { return __hip_atomic_load(p, __ATOMIC_RELAXED, __HIP_MEMORY_SCOPE_AGENT); }
DEVI unsigned xb_add(unsigned* p, unsigned v) { return __hip_atomic_fetch_add(p, v, __ATOMIC_RELAXED, __HIP_MEMORY_SCOPE_AGENT); }
DEVI unsigned xb_xcc_id() { return (unsigned)__builtin_amdgcn_s_getreg((3 << 11) | 20) & 0xFu; }
#define XB_SPIN(cond, bar) do { unsigned _sp = 0; while (cond) { __builtin_amdgcn_s_sleep(1); \
    if ((++_sp & 255u) == 0u) { if (xb_ld(&(bar)[XB_TMO])) break; if (_sp > XB_SPIN_CAP) { atomicAdd(&(bar)[XB_TMO], 1u); break; } } } } while (0)
struct XcdBarrier { unsigned* bar; unsigned x; volatile LAS unsigned* st; };
DEVI XcdBarrier xcd_barrier_post(unsigned* bar, volatile LAS unsigned* st) {
  XcdBarrier b; b.bar = bar; b.x = xb_xcc_id(); b.st = st;
  if (threadIdx.x == 0) (void)xb_add(&bar[XB_XCNT(b.x)], 1u);
  return b;
}
DEVI void xcd_barrier_complete(unsigned* bar, unsigned x, unsigned& nloc, unsigned& nx) {
  const unsigned G = gridDim.x * gridDim.y * gridDim.z;
  unsigned sum, cnt, mine, sp = 0u;
  for (;;) {
    sum = 0u; cnt = 0u; mine = 0u;
#pragma unroll
    for (unsigned j = 0; j < 16; ++j) { const unsigned c = xb_ld(&bar[XB_XCNT(j)]); sum += c; cnt += (c > 0u) ? 1u : 0u; mine = (j == x) ? c : mine; }
    if (sum == G) break;
    __builtin_amdgcn_s_sleep(1);
    if ((++sp & 255u) == 0u) { if (xb_ld(&bar[XB_TMO])) break; if (sp > XB_SPIN_CAP) { atomicAdd(&bar[XB_TMO], 1u); break; } }
  }
  nloc = mine > 0u ? mine : 1u; nx = cnt > 0u ? cnt : 1u;
}
DEVI void xcd_barrier(const XcdBarrier& b) {
  asm volatile("s_waitcnt vmcnt(0)" ::: "memory");
  __syncthreads();
  if (threadIdx.x == 0) {
    unsigned* bar = b.bar;
    __builtin_amdgcn_s_waitcnt(0);
    unsigned nloc = b.st[0], nx = b.st[1];
    if (nloc == 0u) { xcd_barrier_complete(bar, b.x, nloc, nx); b.st[0] = nloc; b.st[1] = nx; }
    const unsigned old = xb_add(&bar[XB_XSUB(b.x)], 1u);
    const unsigned gen = old / nloc;
    if (old + 1u == (gen + 1u) * nloc) {
      __builtin_amdgcn_fence(__ATOMIC_RELEASE, "agent");
      asm volatile("s_waitcnt vmcnt(0)" ::: "memory");
      const unsigned og = xb_add(&bar[XB_TOP], 1u);
      const unsigned tg = og / nx;
      if (og + 1u == (tg + 1u) * nx) xb_add(&bar[XB_TOPGEN], 1u);
      else XB_SPIN(xb_ld(&bar[XB_TOPGEN]) == tg, bar);
      __builtin_amdgcn_fence(__ATOMIC_ACQUIRE, "agent");
      xb_add(&bar[XB_XGEN(b.x)], 1u);
      asm volatile("s_waitcnt vmcnt(0)" ::: "memory");
    } else {
      XB_SPIN(xb_ld(&bar[XB_XGEN(b.x)]) == gen, bar);
      __builtin_amdgcn_fence(__ATOMIC_ACQUIRE, "agent");
      asm volatile("s_waitcnt vmcnt(0)" ::: "memory");
    }
  }
  __syncthreads();
}

struct Params;
typedef const __attribute__((address_space(4))) Params* PP;
DEVI int tidx_() { int t; asm volatile("v_mov_b32 %0, %1" : "=v"(t) : "v"((int)threadIdx.x)); return t; }
DEVI int bidx_() { int t; asm volatile("s_mov_b32 %0, %1" : "=s"(t) : "s"((int)blockIdx.x)); return t; }
DEVI int gdim_() { int t; asm volatile("s_mov_b32 %0, %1" : "=s"(t) : "s"((int)gridDim.x)); return t; }
#define TIDX tidx_()
#define BIDX bidx_()
#define GDIM gdim_()
struct Params {
  const float *x, *c, *ctx, *c_ctx, *ada_w, *ada_b, *norm1_w, *norm2_w, *w_in, *b_in, *conv_w, *conv_b, *ml_norm_w,
      *qa_norm, *wq_b, *kva_norm, *wkv_b, *qn_w, *kn_w, *ret_norm_w, *w_branch, *w_out, *router_w, *w1, *w3, *w2;
  float* out;
  unsigned* bar; unsigned* ctr;
  u16 *Wt_in, *Wt_qb, *Wt_kvb, *Wt_br, *Wt_out, *We13, *We2;
  float *mod, *rope, *xw, *gates;
  u16 *hb, *P, *Q, *K, *Vt, *ya, *yb, *yc;
  float *dC, *dN, *dM, *nin, *min_, *dR;
  u16 *Cin, *Rin;
  float *aff, *rgate, *attb;
  int *ridx, *sel;
  u16 *hid, *Y, *Xg;
  u16* Kc;
  float* gq;
};

DEVI int row_cond(int r) { return r < TL ? (r >> 13) : 2; }
DEVI const float* xin_row(PP p, int l, int r) {
  if (l == 0) return r < TL ? p->x + (size_t)r * DM : p->ctx + (size_t)(r - TL) * DM;
  return p->xw + (size_t)r * DM;
}
DEVI const float* modp(PP p, int l, int cond, int chunk) { return p->mod + ((size_t)(l * 3 + cond) * 6 + chunk) * DM; }

constexpr int GBK = 64, GLD = 72;

template <int WM, int WN, int MT, int NT>
struct GemmT {
  static constexpr int BM = WM * MT * 32, BN = WN * NT * 32;
  static constexpr int XCH = BM * 8 / NTHR, WCH = (BN * 8 + NTHR - 1) / NTHR;
  static constexpr int STAGE = (BM + BN) * GLD;
  static_assert(WM * WN == 8, "8 waves");
  static_assert(2 * STAGE * 2 <= LDS_BYTES - 64, "LDS");

  template <class XRow, bool SSQ = false>
  static DEVI void kloop(f32x16 (&acc)[MT][NT], const XRow& xrow, const u16* __restrict__ wbase, int wld, int K, u16* sm, float* ssq = nullptr) {
    const int tid = TIDX, lane = tid & 63, wid = tid >> 6, c = lane & 31, hh = lane >> 5;
    const int wm = wid / WN, wn = wid % WN;
    const u16* xp[XCH]; const u16* wp[WCH];
#pragma unroll
    for (int i = 0; i < XCH; ++i) { const int ch = tid + i * NTHR; xp[i] = xrow(ch >> 3) + (ch & 7) * 8; }
#pragma unroll
    for (int i = 0; i < WCH; ++i) { const int ch = tid + i * NTHR; const int rr = (ch >> 3) < BN ? (ch >> 3) : BN - 1; wp[i] = wbase + (size_t)rr * wld + (ch & 7) * 8; }
    u32x4 xr0[XCH], wr0[WCH], xr1[XCH], wr1[WCH];
    const int nk = K / GBK;
    float ssq_ = 0.f;
#define G_LOAD(XR, WR, kt) do { _Pragma("unroll") for (int i = 0; i < XCH; ++i) XR[i] = *reinterpret_cast<const u32x4*>(xp[i] + (kt) * GBK); \
      _Pragma("unroll") for (int i = 0; i < WCH; ++i) WR[i] = *reinterpret_cast<const u32x4*>(wp[i] + (kt) * GBK); } while (0)
#define G_WRITE(XR, WR, st) do { u16* xs_ = sm + (st) * STAGE; u16* ws_ = xs_ + BM * GLD; \
      _Pragma("unroll") for (int i = 0; i < XCH; ++i) { const int ch = tid + i * NTHR; *reinterpret_cast<u32x4*>(xs_ + (ch >> 3) * GLD + (ch & 7) * 8) = XR[i]; } \
      _Pragma("unroll") for (int i = 0; i < WCH; ++i) { const int ch = tid + i * NTHR; if ((ch >> 3) < BN) *reinterpret_cast<u32x4*>(ws_ + (ch >> 3) * GLD + (ch & 7) * 8) = WR[i]; } } while (0)
    auto compute = [&](int st) {
      const u16* xs = sm + st * STAGE + (wm * MT * 32 + c) * GLD + hh * 8;
      const u16* ws = sm + st * STAGE + BM * GLD + (wn * NT * 32 + c) * GLD + hh * 8;
#pragma unroll
      for (int ks = 0; ks < GBK / 16; ++ks) {
        bf16x8 xf[MT], wf[NT];
#pragma unroll
        for (int m = 0; m < MT; ++m) xf[m] = ld_frag(xs + m * 32 * GLD + ks * 16);
#pragma unroll
        for (int n = 0; n < NT; ++n) wf[n] = ld_frag(ws + n * 32 * GLD + ks * 16);
#pragma unroll
        for (int m = 0; m < MT; ++m)
#pragma unroll
          for (int n = 0; n < NT; ++n) acc[m][n] = mfma(wf[n], xf[m], acc[m][n]);
        if constexpr (SSQ) { const u32x4 t_ = __builtin_bit_cast(u32x4, xf[0]); ssq_ += sumsq8_(t_); }
      }
    };
    G_LOAD(xr0, wr0, 0); G_WRITE(xr0, wr0, 0);
    if (nk > 1) G_LOAD(xr0, wr0, 1);
    __syncthreads();
    for (int kt = 0; kt < nk; kt += 2) {
      if (kt + 2 < nk) G_LOAD(xr1, wr1, kt + 2);
      compute(0);
      if (kt + 1 < nk) G_WRITE(xr0, wr0, 1);
      __syncthreads();
      if (kt + 1 >= nk) break;
      if (kt + 3 < nk) G_LOAD(xr0, wr0, kt + 3);
      compute(1);
      if (kt + 2 < nk) G_WRITE(xr1, wr1, 0);
      __syncthreads();
    }
#undef G_LOAD
#undef G_WRITE
    if constexpr (SSQ) *ssq = ssq_;
  }
};
typedef GemmT<4, 2, 2, 2> GemmA;
typedef GemmT<8, 1, 1, 3> GemmQ;
typedef GemmT<8, 1, 1, 6> GemmQ2;
typedef GemmT<8, 1, 1, 4> GemmKV;

struct XRowLin { const u16* base; size_t ld; DEVI const u16* operator()(int r) const { return base + (size_t)r * ld; } };
struct XRowIdx { const u16* base; const int* idx; DEVI const u16* operator()(int r) const { return base + (size_t)idx[r] * DM; } };

template <int MT, int NT> DEVI void zero_acc(f32x16 (&acc)[MT][NT]) {
#pragma unroll
  for (int m = 0; m < MT; ++m)
#pragma unroll
    for (int n = 0; n < NT; ++n)
#pragma unroll
      for (int i = 0; i < 16; ++i) acc[m][n][i] = 0.f;
}
DEVI void st_bf4(u16* p, float a, float b, float c, float d) { u32x2 v = {cvtpk(a, b), cvtpk(c, d)}; *reinterpret_cast<u32x2*>(p) = v; }


namespace fg {
constexpr int BM = 256, BK = 64, HALF = 128, HTB = HALF * BK * 2, STAGE_BYTES = 8 * HTB, NXCD = 8, WGM = 4;
DEVI int lds_byte(int r, int c) { const int st = (r >> 4) * 2 + (c >> 5), rr = r & 15, cc = c & 31, ob = rr * 64 + cc * 2; return st * 1024 + (ob ^ (((ob >> 9) & 1) << 5)); }
DEVI void stage_rc(int b, int& R, int& C) { const int st = b / 1024, sb = b % 1024, swz = sb ^ (((sb >> 9) & 1) << 5); R = (st >> 1) * 16 + swz / 64; C = (st & 1) * 32 + (swz % 64) / 2; }
DEVI int perm32(int rho) { const int n = rho >> 4, i = rho & 15; return 8 * (i >> 2) + 4 * n + (i & 3); }
struct Unit { int pm, pn; };
struct Gemm { const u16* A; const u16* Bt; int K; const int* gidx; };
struct StaticOrder {
  int nM, nN, nwg, G, c;
  DEVI void init(int nM_, int nN_, int G_, int c_) { nM = nM_; nN = nN_; nwg = nM * nN; G = G_; c = c_; }
  DEVI bool next(int i, Unit& u) const {
    const long L = (long)i * G + c; if (L >= nwg) return false;
    int wgid = (int)L; { const int q = nwg / NXCD, r = nwg % NXCD, xcd = wgid % NXCD, off = wgid / NXCD; wgid = (xcd < r ? xcd * (q + 1) : r * (q + 1) + (xcd - r) * q) + off; }
    const int nig = WGM * nN, gid = wgid / nig, fm = gid * WGM, gsz = (nM - fm) < WGM ? (nM - fm) : WGM;
    u.pm = fm + ((wgid % nig) % gsz); u.pn = (wgid % nig) / gsz; return true;
  }
};
struct ExpertOrder {
  int mE, nE, strideM, total, G, c;
  DEVI void init(int mE_, int nE_, int strideM_, int G_, int c_) { mE = mE_; nE = nE_; strideM = strideM_; total = NE * mE * nE; G = G_; c = c_; }
  DEVI bool next(int i, Unit& u) const {
    const int L = i * G + c; if (L >= total) return false;
    if (G == 256 && mE == 8) {
      const int x = c & 7, j = c >> 3;
      int e, m, n;
      if (nE == 8) { e = 4 * i + (x >> 1); m = (x & 1) * 4 + (j >> 3); n = j & 7; }
      else { e = 8 * i + x; m = j >> 2; n = j & 3; }
      u.pm = e * strideM + m; u.pn = e * nE + n; return true;
    }
    const int e = L / (mE * nE), r = L % (mE * nE);
    u.pm = e * strideM + r % mE; u.pn = e * nE + r / mE; return true;
  }
};

template <class Epi, class Sched, bool GATHER = false>
DEVI void gemm_phase(LAS unsigned char* lds, const Gemm g, const Sched& S, const Epi& E) {
  const int tid = TIDX, wid = __builtin_amdgcn_readfirstlane(tid >> 6), lane = tid & 63, wr = wid >> 2, wc = wid & 3, fr = lane & 15, fq = lane >> 4;
  const int K = g.K, nt = K / BK;
  unsigned voffA[2], voffB[2];
#pragma unroll
  for (int i = 0; i < 2; ++i) { int R, C; stage_rc(tid * 16 + i * 8192, R, C); const int Rb = Epi::PERM ? ((R & ~31) + perm32(R & 31)) : R;
    voffA[i] = (unsigned)(R * K + C) * 2u; voffB[i] = (unsigned)(Rb * K + C) * 2u; }
  unsigned gc[2][2], gn[2][2]; int gR[2]; unsigned gCb[2];
  if constexpr (GATHER) {
#pragma unroll
    for (int i = 0; i < 2; ++i) { int R, C; stage_rc(tid * 16 + i * 8192, R, C); gR[i] = R; gCb[i] = (unsigned)C * 2u; }
  }
#define FG_GOFFS(pm_, O) do { _Pragma("unroll") for (int _h = 0; _h < 2; ++_h) _Pragma("unroll") for (int _i = 0; _i < 2; ++_i) \
    O[_h][_i] = (unsigned)g.gidx[(pm_) * BM + _h * HALF + gR[_i]] * (unsigned)(K * 2) + gCb[_i]; } while (0)
#define FG_STAGE_G(bufoff, o0, o1, kb) do { \
    __builtin_amdgcn_global_load_lds((const unsigned*)((const char*)g.A + (size_t)(kb) + (o0)), (LAS unsigned*)(lds + (bufoff) + ldsw), 16, 0, 0); \
    __builtin_amdgcn_global_load_lds((const unsigned*)((const char*)g.A + (size_t)(kb) + (o1)), (LAS unsigned*)(lds + (bufoff) + ldsw + 8192), 16, 0, 0); } while (0)
  const size_t kstep = (size_t)(BK * 2);
  const size_t hstep = (size_t)HALF * K * 2;
  const size_t tstep = 2 * hstep;
  const unsigned ldsw = (unsigned)wid * 1024u;
  const int aoff = lds_byte(wr * 64 + fr, fq * 8), boff = lds_byte(wc * 32 + fr, fq * 8);
#define FG_SA(b, h) (((b) * 2 + (h)) * HTB)
#define FG_SB(b, h) ((4 + (b) * 2 + (h)) * HTB)
#define FG_STAGE(bufoff, gbase, voff) do { _Pragma("unroll") for (int _i = 0; _i < 2; ++_i) \
    __builtin_amdgcn_global_load_lds((const unsigned*)((const char*)(gbase) + (voff)[_i]), (LAS unsigned*)(lds + (bufoff) + ldsw + _i * 8192), 16, 0, 0); } while (0)
#define FG_LDA(dst, b, h) do { _Pragma("unroll") for (int m = 0; m < 4; ++m) _Pragma("unroll") for (int k = 0; k < 2; ++k) dst[m][k] = *(const LAS bf16x8*)(lds + FG_SA(b, h) + aoff + m * 2048 + k * 1024); } while (0)
#define FG_LDB(dst, b, h) do { _Pragma("unroll") for (int n = 0; n < 2; ++n) _Pragma("unroll") for (int k = 0; k < 2; ++k) dst[n][k] = *(const LAS bf16x8*)(lds + FG_SB(b, h) + boff + n * 2048 + k * 1024); } while (0)
#define FG_MMA(ai, bj, At, Bt) do { __builtin_amdgcn_s_setprio(1); _Pragma("unroll") for (int m = 0; m < 4; ++m) _Pragma("unroll") for (int n = 0; n < 2; ++n) _Pragma("unroll") for (int k = 0; k < 2; ++k) \
    acc[ai][bj][m][n] = __builtin_amdgcn_mfma_f32_16x16x32_bf16(Bt[n][k], At[m][k], acc[ai][bj][m][n], 0, 0, 0); __builtin_amdgcn_s_setprio(0); } while (0)
#define FG_WAIT_V(n) asm volatile("s_waitcnt vmcnt(" #n ")" ::: "memory")
#define FG_WAIT_L(n) asm volatile("s_waitcnt lgkmcnt(" #n ")" ::: "memory")
#define FG_BAR __builtin_amdgcn_s_barrier()
#define FG_SCHED __builtin_amdgcn_sched_barrier(0)
  Unit cur, nxt; int ui = 0;
  if (!S.next(0, cur)) return;
  f32x4 acc[2][2][4][2];
#pragma unroll
  for (int a = 0; a < 2; ++a)
#pragma unroll
    for (int b = 0; b < 2; ++b)
#pragma unroll
      for (int m = 0; m < 4; ++m)
#pragma unroll
        for (int n = 0; n < 2; ++n) acc[a][b][m][n] = (f32x4){0.f, 0.f, 0.f, 0.f};
  bf16x8 At[4][2], B0[2][2], B1[2][2];
  const char* cA = (const char*)g.A + (size_t)cur.pm * tstep; const char* cB = (const char*)g.Bt + (size_t)cur.pn * tstep;
  if constexpr (GATHER) { FG_GOFFS(cur.pm, gc); }
  FG_STAGE(FG_SB(0, 0), cB, voffB);
  if constexpr (GATHER) FG_STAGE_G(FG_SA(0, 0), gc[0][0], gc[0][1], 0); else FG_STAGE(FG_SA(0, 0), cA, voffA);
  FG_STAGE(FG_SB(0, 1), cB + hstep, voffB);
  if constexpr (GATHER) FG_STAGE_G(FG_SA(0, 1), gc[1][0], gc[1][1], 0); else FG_STAGE(FG_SA(0, 1), cA + hstep, voffA);
  if (wr == 1) FG_BAR;
  FG_WAIT_V(4); FG_BAR;
  FG_STAGE(FG_SB(1, 0), cB + kstep, voffB);
  if constexpr (GATHER) FG_STAGE_G(FG_SA(1, 0), gc[0][0], gc[0][1], kstep); else FG_STAGE(FG_SA(1, 0), cA + kstep, voffA);
  FG_STAGE(FG_SB(1, 1), cB + hstep + kstep, voffB);
  FG_WAIT_V(6); FG_BAR;
  for (;;) {
    const bool has_next = S.next(ui + 1, nxt);
    const char* nA = has_next ? (const char*)g.A + (size_t)nxt.pm * tstep : cA; const char* nB = has_next ? (const char*)g.Bt + (size_t)nxt.pn * tstep : cB;
    if constexpr (GATHER) { if (has_next) { FG_GOFFS(nxt.pm, gn); } else {
#pragma unroll
        for (int _h = 0; _h < 2; ++_h) { gn[_h][0] = gc[_h][0]; gn[_h][1] = gc[_h][1]; } } }
    for (int t = 0; t < nt; t += 2) {
      const bool last = (t == nt - 2);
      const char* a1 = cA + (size_t)(t + 1) * kstep;
      const char* a2 = last ? nA : cA + (size_t)(t + 2) * kstep; const char* b2 = last ? nB : cB + (size_t)(t + 2) * kstep;
      const char* a3 = a2 + kstep; const char* b3 = b2 + kstep;
      const size_t kb1 = (size_t)(t + 1) * kstep, kb2 = last ? 0 : (size_t)(t + 2) * kstep;
      unsigned o00 = 0, o01 = 0, o10 = 0, o11 = 0;
      if constexpr (GATHER) { o00 = last ? gn[0][0] : gc[0][0]; o01 = last ? gn[0][1] : gc[0][1]; o10 = last ? gn[1][0] : gc[1][0]; o11 = last ? gn[1][1] : gc[1][1]; }
      FG_LDB(B0, 0, 0); FG_SCHED; FG_LDA(At, 0, 0); if constexpr (GATHER) FG_STAGE_G(FG_SA(1, 1), gc[1][0], gc[1][1], kb1); else FG_STAGE(FG_SA(1, 1), a1 + hstep, voffA);
      FG_WAIT_L(8); FG_BAR; FG_WAIT_L(0); FG_MMA(0, 0, At, B0); FG_BAR; FG_SCHED;
      FG_LDB(B1, 0, 1); FG_STAGE(FG_SB(0, 0), b2, voffB);
      FG_BAR; FG_WAIT_L(0); FG_MMA(0, 1, At, B1); FG_BAR;
      FG_LDA(At, 0, 1); if constexpr (GATHER) FG_STAGE_G(FG_SA(0, 0), o00, o01, kb2); else FG_STAGE(FG_SA(0, 0), a2, voffA);
      FG_BAR; FG_WAIT_L(0); FG_MMA(1, 0, At, B0); FG_BAR; FG_SCHED;
      FG_STAGE(FG_SB(0, 1), b2 + hstep, voffB);
      FG_WAIT_V(6); FG_BAR; FG_MMA(1, 1, At, B1); FG_BAR;
      FG_LDB(B0, 1, 0); FG_SCHED; FG_LDA(At, 1, 0); if constexpr (GATHER) FG_STAGE_G(FG_SA(0, 1), o10, o11, kb2); else FG_STAGE(FG_SA(0, 1), a2 + hstep, voffA);
      FG_WAIT_L(8); FG_BAR; FG_WAIT_L(0); FG_MMA(0, 0, At, B0); FG_BAR; FG_SCHED;
      FG_LDB(B1, 1, 1); FG_STAGE(FG_SB(1, 0), b3, voffB);
      FG_BAR; FG_WAIT_L(0); FG_MMA(0, 1, At, B1); FG_BAR;
      FG_LDA(At, 1, 1); if constexpr (GATHER) FG_STAGE_G(FG_SA(1, 0), o00, o01, kb2 + kstep); else FG_STAGE(FG_SA(1, 0), a3, voffA);
      FG_BAR; FG_WAIT_L(0); FG_MMA(1, 0, At, B0); FG_BAR; FG_SCHED;
      FG_STAGE(FG_SB(1, 1), b3 + hstep, voffB);
      FG_WAIT_V(6); FG_BAR; FG_MMA(1, 1, At, B1); FG_BAR;
    }
    E(acc, cur, wr, wc, fr, fq);
    if (!has_next) break;
#pragma unroll
    for (int a = 0; a < 2; ++a)
#pragma unroll
      for (int b = 0; b < 2; ++b)
#pragma unroll
        for (int m = 0; m < 4; ++m)
#pragma unroll
          for (int n = 0; n < 2; ++n) acc[a][b][m][n] = (f32x4){0.f, 0.f, 0.f, 0.f};
    cur = nxt; cA = nA; cB = nB; ++ui;
    if constexpr (GATHER) {
#pragma unroll
      for (int _h = 0; _h < 2; ++_h) { gc[_h][0] = gn[_h][0]; gc[_h][1] = gn[_h][1]; } }
  }
  FG_WAIT_V(0);
  if (wr == 0) FG_BAR;
  FG_BAR;
#undef FG_SA
#undef FG_SB
#undef FG_STAGE
#undef FG_STAGE_G
#undef FG_GOFFS
#undef FG_LDA
#undef FG_LDB
#undef FG_MMA
#undef FG_WAIT_V
#undef FG_WAIT_L
#undef FG_BAR
#undef FG_SCHED
}
typedef f32x4 Acc[2][2][4][2];

struct EpiInproj {
  static constexpr bool PERM = true;
  u16* P; float* gates; const float* bias;
  DEVI void operator()(const Acc& acc, const Unit& u, int wr, int wc, int fr, int fq) const {
    const int row0 = u.pm * BM + wr * 64 + fr, colb = u.pn * BM + wc * 32 + 8 * fq;
#pragma unroll
    for (int bj = 0; bj < 2; ++bj) {
      const int col = colb + bj * HALF;
      if (col < NIN) {
        const f32x4 b0 = *reinterpret_cast<const f32x4*>(bias + col), b1 = *reinterpret_cast<const f32x4*>(bias + col + 4);
#pragma unroll
        for (int ai = 0; ai < 2; ++ai)
#pragma unroll
          for (int m = 0; m < 4; ++m) {
            const int row = row0 + ai * HALF + m * 16;
            const f32x4 v0 = acc[ai][bj][m][0] + b0, v1 = acc[ai][bj][m][1] + b1;
            u32x4 w = {cvtpk(v0[0], v0[1]), cvtpk(v0[2], v0[3]), cvtpk(v1[0], v1[1]), cvtpk(v1[2], v1[3])};
            *reinterpret_cast<u32x4*>(P + (size_t)row * NINP + col) = w;
            if (col >= O_GATES && col < O_GATES + 32) { float* gp = gates + (size_t)row * 32 + (col - O_GATES); *reinterpret_cast<f32x4*>(gp) = v0; *reinterpret_cast<f32x4*>(gp + 4) = v1; }
          }
      }
    }
  }
};
struct EpiWout {
  static constexpr bool PERM = false;
  const float* xold; float* xw; const float* g1_0; const float* g1_1;
  DEVI void operator()(const Acc& acc, const Unit& u, int wr, int wc, int fr, int fq) const {
    const int row0 = u.pm * BM + wr * 64 + fr, col0 = u.pn * BM + wc * 32 + 4 * fq;
    const float* g1 = (u.pm * BM) < SEQ ? g1_0 : g1_1;
    f32x4 gv[2][2];
#pragma unroll
    for (int bj = 0; bj < 2; ++bj)
#pragma unroll
      for (int n = 0; n < 2; ++n) gv[bj][n] = *reinterpret_cast<const f32x4*>(g1 + col0 + bj * HALF + n * 16);
#pragma unroll
    for (int ai = 0; ai < 2; ++ai) {
      f32x4 xv[4][2][2];
#pragma unroll
      for (int m = 0; m < 4; ++m) {
        const size_t off = (size_t)(row0 + ai * HALF + m * 16) * DM + col0;
#pragma unroll
        for (int bj = 0; bj < 2; ++bj)
#pragma unroll
          for (int n = 0; n < 2; ++n) xv[m][bj][n] = *reinterpret_cast<const f32x4*>(xold + off + bj * HALF + n * 16);
      }
#pragma unroll
      for (int m = 0; m < 4; ++m) {
        const size_t off = (size_t)(row0 + ai * HALF + m * 16) * DM + col0;
#pragma unroll
        for (int bj = 0; bj < 2; ++bj)
#pragma unroll
          for (int n = 0; n < 2; ++n) *reinterpret_cast<f32x4*>(xw + off + bj * HALF + n * 16) = xv[m][bj][n] + gv[bj][n] * acc[ai][bj][m][n];
      }
    }
  }
};
struct EpiSwiglu {
  static constexpr bool PERM = true;
  u16* hid;
  DEVI void operator()(const Acc& acc, const Unit& u, int wr, int wc, int fr, int fq) const {
    const int row0 = u.pm * BM + wr * 64 + fr, col = (u.pn & 7) * HALF + wc * 32 + 8 * fq;
#pragma unroll
    for (int ai = 0; ai < 2; ++ai)
#pragma unroll
      for (int m = 0; m < 4; ++m) {
        float o[8];
#pragma unroll
        for (int n = 0; n < 2; ++n)
#pragma unroll
          for (int j = 0; j < 4; ++j) o[4 * n + j] = siluf_(acc[ai][0][m][n][j]) * acc[ai][1][m][n][j];
        u32x4 w = {cvtpk(o[0], o[1]), cvtpk(o[2], o[3]), cvtpk(o[4], o[5]), cvtpk(o[6], o[7])};
        *reinterpret_cast<u32x4*>(hid + (size_t)(row0 + ai * HALF + m * 16) * FF + col) = w;
      }
  }
};
struct EpiY {
  static constexpr bool PERM = true;
  u16* Y; const float* gate;
  DEVI void operator()(const Acc& acc, const Unit& u, int wr, int wc, int fr, int fq) const {
    const int row0 = u.pm * BM + wr * 64 + fr, colb = (u.pn & 3) * BM + wc * 32 + 8 * fq;
    float gts[2][4];
#pragma unroll
    for (int ai = 0; ai < 2; ++ai)
#pragma unroll
      for (int m = 0; m < 4; ++m) gts[ai][m] = gate[row0 + ai * HALF + m * 16];
#pragma unroll
    for (int ai = 0; ai < 2; ++ai)
#pragma unroll
      for (int m = 0; m < 4; ++m) {
        const int row = row0 + ai * HALF + m * 16; const float gt = gts[ai][m];
#pragma unroll
        for (int bj = 0; bj < 2; ++bj) {
          const f32x4 v0 = acc[ai][bj][m][0] * gt, v1 = acc[ai][bj][m][1] * gt;
          u32x4 w = {cvtpk(v0[0], v0[1]), cvtpk(v0[2], v0[3]), cvtpk(v1[0], v1[1]), cvtpk(v1[2], v1[3])};
          *reinterpret_cast<u32x4*>(Y + (size_t)row * DM + colb + bj * HALF) = w;
        }
      }
  }
};
struct MergeZOrder {
  int G, c;
  DEVI void init(int G_, int c_) { G = G_; c = c_; }
  DEVI bool next(int i, Unit& u) const {
    const int L = i * G + c; if (L >= 3 * 256) return false;
    const int br = L >> 8, T = L & 255, x = T & 7, j = T >> 3;
    u.pm = br * (TT / 256) + x * 8 + (j >> 2); u.pn = br * 4 + (j & 3); return true;
  }
};
struct EpiZ {
  static constexpr bool PERM = true;
  u16* z01; u16* z2;
  DEVI void operator()(const Acc& acc, const Unit& u, int wr, int wc, int fr, int fq) const {
    const int br = u.pn >> 2, nt = u.pn & 3, mt = u.pm - br * (TT / 256);
    u16* base = br < 2 ? z01 + (size_t)br * TT * DM : z2;
    const int row0 = mt * BM + wr * 64 + fr, colb = nt * BM + wc * 32 + 8 * fq;
#pragma unroll
    for (int ai = 0; ai < 2; ++ai)
#pragma unroll
      for (int m = 0; m < 4; ++m) {
        const int row = row0 + ai * HALF + m * 16;
#pragma unroll
        for (int bj = 0; bj < 2; ++bj) {
          const f32x4 v0 = acc[ai][bj][m][0], v1 = acc[ai][bj][m][1];
          u32x4 w = {cvtpk(v0[0], v0[1]), cvtpk(v0[2], v0[3]), cvtpk(v1[0], v1[1]), cvtpk(v1[2], v1[3])};
          *reinterpret_cast<u32x4*>(base + (size_t)row * DM + colb + bj * HALF) = w;
        }
      }
  }
};
}
typedef GemmT<2, 4, 1, 1> GemmS;

struct CvtD { const float* src; u16* dst; const float* ksc; int ldn, ldk; };
DEVI void cvt_load(const CvtD& d, f32x4 (&v)[16]) {
  const int lane = TIDX & 63, kg = lane >> 3, nq = lane & 7;
  const float* s = d.src + (size_t)(kg * 8) * d.ldn + nq * 4;
#pragma unroll
  for (int h = 0; h < 2; ++h)
#pragma unroll
    for (int i = 0; i < 8; ++i) v[h * 8 + i] = __builtin_nontemporal_load(reinterpret_cast<const f32x4*>(s + (size_t)i * d.ldn + h * 32));
}
DEVI void cvt_store(const CvtD& d, f32x4 (&v)[16]) {
  const int lane = TIDX & 63, kg = lane >> 3, nq = lane & 7;
  if (d.ksc) {
    const f32x4 s0 = *reinterpret_cast<const f32x4*>(d.ksc + kg * 8), s1 = *reinterpret_cast<const f32x4*>(d.ksc + kg * 8 + 4);
#pragma unroll
    for (int h = 0; h < 2; ++h)
#pragma unroll
      for (int i = 0; i < 8; ++i) v[h * 8 + i] *= (i < 4 ? s0[i & 3] : s1[i & 3]);
  }
  u16* o = d.dst + (size_t)(nq * 4) * d.ldk + kg * 8;
#pragma unroll
  for (int h = 0; h < 2; ++h)
#pragma unroll
    for (int j = 0; j < 4; ++j) {
      const u32x4 w = {cvtpk(v[h * 8 + 0][j], v[h * 8 + 1][j]), cvtpk(v[h * 8 + 2][j], v[h * 8 + 3][j]), cvtpk(v[h * 8 + 4][j], v[h * 8 + 5][j]), cvtpk(v[h * 8 + 6][j], v[h * 8 + 7][j])};
      __builtin_nontemporal_store(w, reinterpret_cast<u32x4*>(o + (size_t)(h * 32 + j) * d.ldk));
    }
}

constexpr int CT_IN = 16 * 115, CT_QB = 6 * 12, CT_KVB = 4 * 16, CT_BR = 3 * 8 * 16, CT_OUT = 256, CT_E13 = 16 * 2 * 256, CT_E2 = 16 * 256;
constexpr int CT_LAYER = CT_IN + CT_QB + CT_KVB + CT_BR + CT_OUT + CT_E13 + CT_E2;
constexpr int ADA_JOBS = DEPTH * 48;

DEVI CvtD cvt_desc(PP p, int l, int t) {
  CvtD d; d.ksc = nullptr;
  if (t < CT_IN) { const int kt = t / 115, nt = t % 115; d.ldn = NIN; d.ldk = DM;
    d.src = p->w_in + (size_t)l * DM * NIN + (size_t)(kt * 64) * NIN + nt * 64; d.dst = p->Wt_in + (size_t)l * NINP * DM + (size_t)(nt * 64) * DM + kt * 64; return d; }
  t -= CT_IN;
  if (t < CT_QB) { const int kt = t / 12, nt = t % 12; d.ldn = 768; d.ldk = 384; d.ksc = p->qa_norm + l * 384 + kt * 64;
    d.src = p->wq_b + (size_t)l * 384 * 768 + (size_t)(kt * 64) * 768 + nt * 64; d.dst = p->Wt_qb + (size_t)l * 768 * 384 + (size_t)(nt * 64) * 384 + kt * 64; return d; }
  t -= CT_QB;
  if (t < CT_KVB) { const int kt = t / 16, nt = t % 16; d.ldn = 1024; d.ldk = 256; d.ksc = p->kva_norm + l * 256 + kt * 64;
    d.src = p->wkv_b + (size_t)l * 256 * 1024 + (size_t)(kt * 64) * 1024 + nt * 64; d.dst = p->Wt_kvb + (size_t)l * 1024 * 256 + (size_t)(nt * 64) * 256 + kt * 64; return d; }
  t -= CT_KVB;
  if (t < CT_BR) { const int n = t / 128, r = t % 128, kt = r / 16, nt = r % 16; d.ldn = 1024; d.ldk = 512;
    d.src = p->w_branch + ((size_t)l * 3 + n) * 512 * 1024 + (size_t)(kt * 64) * 1024 + nt * 64; d.dst = p->Wt_br + ((size_t)l * 3 + n) * 1024 * 512 + (size_t)(nt * 64) * 512 + kt * 64; return d; }
  t -= CT_BR;
  if (t < CT_OUT) { const int kt = t / 16, nt = t % 16; d.ldn = DM; d.ldk = DM;
    d.src = p->w_out + (size_t)l * DM * DM + (size_t)(kt * 64) * DM + nt * 64; d.dst = p->Wt_out + (size_t)l * DM * DM + (size_t)(nt * 64) * DM + kt * 64; return d; }
  t -= CT_OUT;
  if (t < CT_E13) { const int e = t / 512, r = t % 512, which = r / 256, r2 = r % 256, kt = r2 / 16, nt = r2 % 16; d.ldn = FF; d.ldk = DM;
    const int n0 = nt * 64, drow = (n0 >> 7) * 256 + which * 128 + (n0 & 127);
    d.src = (which ? p->w3 : p->w1) + ((size_t)l * NE + e) * DM * FF + (size_t)(kt * 64) * FF + n0;
    d.dst = p->We13 + ((size_t)l * NE + e) * 2048 * DM + (size_t)drow * DM + kt * 64; return d; }
  t -= CT_E13;
  { const int e = t / 256, r = t % 256, kt = r / 16, nt = r % 16; d.ldn = DM; d.ldk = FF;
    d.src = p->w2 + ((size_t)l * NE + e) * FF * DM + (size_t)(kt * 64) * DM + nt * 64; d.dst = p->We2 + ((size_t)l * NE + e) * DM * FF + (size_t)(nt * 64) * FF + kt * 64; }
  return d;
}
constexpr int CVT_PER_JOB = 32, CVT_JOBS = (CT_LAYER + CVT_PER_JOB - 1) / CVT_PER_JOB;
constexpr int INPROJ_UNITS = (TT / 256) * (NINP / 256), CVT_FILL_PER_WG = 32;
DEVI int cvt_fill_tiles() { const int g = (int)GDIM, rem = INPROJ_UNITS % g; return (g == 256 && rem > 0) ? (g - rem) * CVT_FILL_PER_WG : 0; }
DEVI void cvt_range(PP p, int l, int t0, int t1);
DEVI void cvt_bundle(PP p, int l, int j, int tend = CT_LAYER) {
  const int t0 = j * CVT_PER_JOB, t1 = (t0 + CVT_PER_JOB) < tend ? (t0 + CVT_PER_JOB) : tend;
  if (t0 < t1) cvt_range(p, l, t0, t1);
}
DEVI void cvt_range(PP p, int l, int t0, int t1) {
  const int tA = t0 + __builtin_amdgcn_readfirstlane(TIDX >> 6), tB = tA + 8, tC = tA + 16, tD = tA + 24;
  f32x4 a[16], b[16];
  CvtD dA, dB;
  if (tA < t1) { dA = cvt_desc(p, l, tA); cvt_load(dA, a); }
  if (tB < t1) { dB = cvt_desc(p, l, tB); cvt_load(dB, b); }
  if (tA < t1) cvt_store(dA, a);
  if (tC < t1) { dA = cvt_desc(p, l, tC); cvt_load(dA, a); }
  if (tB < t1) cvt_store(dB, b);
  if (tD < t1) { dB = cvt_desc(p, l, tD); cvt_load(dB, b); }
  if (tC < t1) cvt_store(dA, a);
  if (tD < t1) cvt_store(dB, b);
}

DEVI void ada_job(PP p, int job, float* sm) {
  const int l = job / 48, c0 = (job % 48) * 128, tid = TIDX;
  float* sv = sm;
  float* red = sm + 3 * 1024;
  __syncthreads();
  for (int i = tid; i < 3 * 1024; i += NTHR) { const int cd = i >> 10, k = i & 1023; const float v = cd < 2 ? p->c[cd * DM + k] : p->c_ctx[k]; sv[i] = siluf_(v); }
  __syncthreads();
  const int cg = tid & 31, ksp = tid >> 5;
  f32x4 a0 = {0, 0, 0, 0}, a1 = a0, a2 = a0;
  const float* wp = p->ada_w + (size_t)l * DM * 6144 + (size_t)(ksp * 64) * 6144 + c0 + cg * 4;
#pragma unroll 8
  for (int k = 0; k < 64; ++k) {
    const f32x4 w = *reinterpret_cast<const f32x4*>(wp + (size_t)k * 6144);
    const int kk = ksp * 64 + k;
    a0 += w * sv[kk]; a1 += w * sv[1024 + kk]; a2 += w * sv[2048 + kk];
  }
#pragma unroll
  for (int j = 0; j < 4; ++j) { red[(ksp * 3 + 0) * 128 + cg * 4 + j] = a0[j]; red[(ksp * 3 + 1) * 128 + cg * 4 + j] = a1[j]; red[(ksp * 3 + 2) * 128 + cg * 4 + j] = a2[j]; }
  __syncthreads();
  if (tid < 384) { const int cd = tid >> 7, col = tid & 127; float s = p->ada_b[l * 6144 + c0 + col];
#pragma unroll
    for (int k = 0; k < 16; ++k) s += red[(k * 3 + cd) * 128 + col];
    p->mod[(size_t)(l * 3 + cd) * 6144 + c0 + col] = s; }
}

DEVI void phase_prologue(PP p, char* smem) {
  float* sm = reinterpret_cast<float*>(smem);
  for (int j = BIDX; j < ADA_JOBS + 1; j += GDIM) {
    if (j < ADA_JOBS) ada_job(p, j, sm);
    else {
      unsigned* mx = reinterpret_cast<unsigned*>(sm);
      __syncthreads();
      if (TIDX < 2 * DEPTH) mx[TIDX] = 0u;
      __syncthreads();
      if (TIDX < DEPTH * 96) { const int ly = TIDX / 96;
        atomicMax(&mx[ly * 2], __float_as_uint(fabsf(p->qn_w[TIDX]))); atomicMax(&mx[ly * 2 + 1], __float_as_uint(fabsf(p->kn_w[TIDX]))); }
      __syncthreads();
      if (TIDX < DEPTH) p->attb[TIDX] = 96.f * __uint_as_float(mx[TIDX * 2]) * __uint_as_float(mx[TIDX * 2 + 1]) * 0.10206207261596575f * LOG2E * 1.02f;
      for (int i = TIDX; i < 128 * 8; i += NTHR) { const int pos = i >> 3, f = i & 7;
        const float inv = powf(10000.f, -(float)f / 8.f); const float a = (float)pos * inv;
        p->rope[i * 2] = cosf(a); p->rope[i * 2 + 1] = sinf(a); }
    }
  }
  __syncthreads();
  for (int j = (BIDX + 192) % GDIM; j < CVT_JOBS; j += GDIM) cvt_bundle(p, 0, j);
}

template <bool COMBINE, bool FINAL>
DEVI void phase_norm1(PP p, int l) {
  const int lane = TIDX & 63, gw = BIDX * 8 + (TIDX >> 6), nw = GDIM * 8;
  const int nrows = FINAL ? TL : TT;
  const int r0 = (int)((long)gw * nrows / nw), r1 = (int)((long)(gw + 1) * nrows / nw);
  int cur = -1;
  f32x4 Wm[4], Ad[4], G2[4];
  f32x4 nx[4]; int nsv = -1;
  if (r0 < r1) { const float* xr = xin_row(p, l, r0);
#pragma unroll
    for (int i = 0; i < 4; ++i) nx[i] = *reinterpret_cast<const f32x4*>(xr + i * 256 + lane * 4);
    if (COMBINE) nsv = p->sel[(size_t)r0 * 16 + (lane & 15)]; }
  for (int r = r0; r < r1; ++r) {
    f32x4 v[4];
#pragma unroll
    for (int i = 0; i < 4; ++i) v[i] = nx[i];
    const int sv = nsv;
    if (r + 1 < r1) { const float* xr = xin_row(p, l, r + 1);
#pragma unroll
      for (int i = 0; i < 4; ++i) nx[i] = *reinterpret_cast<const f32x4*>(xr + i * 256 + lane * 4);
      if (COMBINE) nsv = p->sel[(size_t)(r + 1) * 16 + (lane & 15)]; }
    const int cond = row_cond(r);
    if (cond != cur) {
      cur = cond;
      if (COMBINE) { const float* g2 = modp(p, l - 1, cond, 5);
#pragma unroll
        for (int i = 0; i < 4; ++i) G2[i] = *reinterpret_cast<const f32x4*>(g2 + i * 256 + lane * 4); }
      if (!FINAL) { const float* nw_ = p->norm1_w + l * DM; const float* sc = modp(p, l, cond, 1); const float* sh = modp(p, l, cond, 0);
#pragma unroll
        for (int i = 0; i < 4; ++i) { const int col = i * 256 + lane * 4;
          Wm[i] = *reinterpret_cast<const f32x4*>(nw_ + col) * (1.f + *reinterpret_cast<const f32x4*>(sc + col)); Ad[i] = *reinterpret_cast<const f32x4*>(sh + col); } }
    }
    if (COMBINE) {
      f32x4 a[4];
#pragma unroll
      for (int i = 0; i < 4; ++i) a[i] = (f32x4){0.f, 0.f, 0.f, 0.f};
      unsigned selm = (unsigned)(__ballot(sv >= 0) & 0xffffull);
      while (selm) {
        const int e0 = __builtin_ctz(selm); selm &= selm - 1;
        const u16* y0 = p->Y + ((size_t)e0 * ESLOTS + __builtin_amdgcn_readlane(sv, e0)) * DM;
        u32x2 t0[4], t1[4];
#pragma unroll
        for (int i = 0; i < 4; ++i) t0[i] = *reinterpret_cast<const u32x2*>(y0 + i * 256 + lane * 4);
        const bool two = selm != 0u;
        if (two) {
          const int e1 = __builtin_ctz(selm); selm &= selm - 1;
          const u16* y1 = p->Y + ((size_t)e1 * ESLOTS + __builtin_amdgcn_readlane(sv, e1)) * DM;
#pragma unroll
          for (int i = 0; i < 4; ++i) t1[i] = *reinterpret_cast<const u32x2*>(y1 + i * 256 + lane * 4);
        }
#pragma unroll
        for (int i = 0; i < 4; ++i) a[i] += (f32x4){bflo(t0[i].x), bfhi(t0[i].x), bflo(t0[i].y), bfhi(t0[i].y)};
        if (two) {
#pragma unroll
          for (int i = 0; i < 4; ++i) a[i] += (f32x4){bflo(t1[i].x), bfhi(t1[i].x), bflo(t1[i].y), bfhi(t1[i].y)};
        }
      }
#pragma unroll
      for (int i = 0; i < 4; ++i) v[i] += G2[i] * a[i];
      float* dst = FINAL ? p->out + (size_t)r * DM : p->xw + (size_t)r * DM;
#pragma unroll
      for (int i = 0; i < 4; ++i) *reinterpret_cast<f32x4*>(dst + i * 256 + lane * 4) = v[i];
    }
    if (!FINAL) {
      float ss = 0.f;
#pragma unroll
      for (int i = 0; i < 4; ++i) ss += v[i][0] * v[i][0] + v[i][1] * v[i][1] + v[i][2] * v[i][2] + v[i][3] * v[i][3];
      ss = wave_sum(ss);
      const float rstd = rsqrtf(ss * (1.f / DM) + EPS);
#pragma unroll
      for (int i = 0; i < 4; ++i) { const int col = i * 256 + lane * 4;
        const f32x4 h = v[i] * rstd * Wm[i] + Ad[i];
        st_bf4(p->hb + (size_t)r * DM + col, h[0], h[1], h[2], h[3]); }
    }
  }
}

DEVI void phase_inproj(PP p, int l, char* smem) {
  fg::StaticOrder S; S.init(TT / 256, NINP / 256, GDIM, BIDX);
  fg::Gemm g{p->hb, p->Wt_in + (size_t)l * NINP * DM, DM, nullptr};
  fg::EpiInproj E{p->P, p->gates, p->b_in + (size_t)l * NIN};
  __syncthreads();
  fg::gemm_phase((LAS unsigned char*)(smem), g, S, E);
  if (l < DEPTH - 1) {
    const int nf = cvt_fill_tiles(), rem = INPROJ_UNITS % (int)GDIM;
    if (nf > 0 && (int)BIDX >= rem) { const int t0 = CT_LAYER - nf + ((int)BIDX - rem) * CVT_FILL_PER_WG; cvt_range(p, l + 1, t0, t0 + CVT_FILL_PER_WG); }
  }
}

DEVI float sumsq8(u32x4 t) {
  float s = 0.f;
#pragma unroll
  for (int j = 0; j < 4; ++j) { const float a = bflo(t[j]), b = bfhi(t[j]); s += a * a + b * b; }
  return s;
}
DEVI void rope_sub(f32x16& a, const float* rope, int t, int hh) {
  const int pr = t >> 6, pc = t & 63;
  const f32x4 r0 = *reinterpret_cast<const f32x4*>(rope + (pr * 8 + 4 * hh) * 2), r1 = *reinterpret_cast<const f32x4*>(rope + (pr * 8 + 4 * hh) * 2 + 4);
  const f32x4 c0 = *reinterpret_cast<const f32x4*>(rope + (pc * 8 + 4 * hh) * 2), c1 = *reinterpret_cast<const f32x4*>(rope + (pc * 8 + 4 * hh) * 2 + 4);
  const float rc[4] = {r0[0], r0[2], r1[0], r1[2]}, rs[4] = {r0[1], r0[3], r1[1], r1[3]};
  const float cc[4] = {c0[0], c0[2], c1[0], c1[2]}, cs[4] = {c0[1], c0[3], c1[1], c1[3]};
#pragma unroll
  for (int j = 0; j < 4; ++j) {
    const float x1 = a[j], x2 = a[4 + j];
    a[j] = x1 * rc[j] - x2 * rs[j]; a[4 + j] = x1 * rs[j] + x2 * rc[j];
    const float y1 = a[8 + j], y2 = a[12 + j];
    a[8 + j] = y1 * cc[j] - y2 * cs[j]; a[12 + j] = y1 * cs[j] + y2 * cc[j];
  }
}

DEVI void mlaq_unit(PP p, int l, int mt, int head, u16* sm) {
  const int lane = TIDX & 63, wid = TIDX >> 6, c = lane & 31, hh = lane >> 5;
  f32x16 acc[1][3]; zero_acc(acc);
  XRowLin xr{p->P + (size_t)mt * 256 * NINP + O_QLAT, (size_t)NINP};
  float ss = 0.f;
  GemmQ::kloop<XRowLin, true>(acc, xr, p->Wt_qb + (size_t)l * 768 * 384 + (size_t)head * 96 * 384, 384, 384, sm, &ss);
  const int row = mt * 256 + wid * 32 + c;
  ss = sum32(ss);
  const float rstd = rsqrtf(ss * (1.f / 384.f) + EPS);
  float s2 = 0.f;
#pragma unroll
  for (int n = 0; n < 3; ++n)
#pragma unroll
    for (int i = 0; i < 16; ++i) { acc[0][n][i] *= rstd; s2 += acc[0][n][i] * acc[0][n][i]; }
  s2 = sum32(s2);
  const float r2 = rsqrtf(s2 * (1.f / 96.f) + EPS);
  const float* qw = p->qn_w + l * 96;
#pragma unroll
  for (int n = 0; n < 3; ++n)
#pragma unroll
    for (int g = 0; g < 4; ++g) { const f32x4 w = *reinterpret_cast<const f32x4*>(qw + 32 * n + 8 * g + 4 * hh);
#pragma unroll
      for (int j = 0; j < 4; ++j) acc[0][n][4 * g + j] *= r2 * w[j]; }
  if (row < TL) rope_sub(acc[0][2], p->rope, row & (SEQ - 1), hh);
  const float qs = 0.10206207261596575f * LOG2E;
  u16* dst = p->Q + (size_t)row * 768 + head * 96;
#pragma unroll
  for (int n = 0; n < 3; ++n)
#pragma unroll
    for (int g = 0; g < 4; ++g) st_bf4(dst + 32 * n + 8 * g + 4 * hh, acc[0][n][4 * g] * qs, acc[0][n][4 * g + 1] * qs, acc[0][n][4 * g + 2] * qs, acc[0][n][4 * g + 3] * qs);
}

DEVI void mlaq_unit2(PP p, int l, int mt, int hp, u16* sm) {
  const int lane = TIDX & 63, wid = TIDX >> 6, c = lane & 31, hh = lane >> 5;
  f32x16 acc[1][6]; zero_acc(acc);
  XRowLin xr{p->P + (size_t)mt * 256 * NINP + O_QLAT, (size_t)NINP};
  float ss = 0.f;
  GemmQ2::kloop<XRowLin, true>(acc, xr, p->Wt_qb + (size_t)l * 768 * 384 + (size_t)hp * 192 * 384, 384, 384, sm, &ss);
  const int row = mt * 256 + wid * 32 + c;
  ss = sum32(ss);
  const float rstd = rsqrtf(ss * (1.f / 384.f) + EPS);
  const float* qw = p->qn_w + l * 96;
  const float qs = 0.10206207261596575f * LOG2E;
#pragma unroll
  for (int hd = 0; hd < 2; ++hd) {
    float s2 = 0.f;
#pragma unroll
    for (int n = 0; n < 3; ++n)
#pragma unroll
      for (int i = 0; i < 16; ++i) { acc[0][3 * hd + n][i] *= rstd; s2 += acc[0][3 * hd + n][i] * acc[0][3 * hd + n][i]; }
    s2 = sum32(s2);
    const float r2 = rsqrtf(s2 * (1.f / 96.f) + EPS);
#pragma unroll
    for (int n = 0; n < 3; ++n)
#pragma unroll
      for (int g = 0; g < 4; ++g) { const f32x4 w = *reinterpret_cast<const f32x4*>(qw + 32 * n + 8 * g + 4 * hh);
#pragma unroll
        for (int j = 0; j < 4; ++j) acc[0][3 * hd + n][4 * g + j] *= r2 * w[j]; }
    if (row < TL) rope_sub(acc[0][3 * hd + 2], p->rope, row & (SEQ - 1), hh);
    u16* dst = p->Q + (size_t)row * 768 + (2 * hp + hd) * 96;
#pragma unroll
    for (int n = 0; n < 3; ++n)
#pragma unroll
      for (int g = 0; g < 4; ++g) st_bf4(dst + 32 * n + 8 * g + 4 * hh, acc[0][3 * hd + n][4 * g] * qs, acc[0][3 * hd + n][4 * g + 1] * qs, acc[0][3 * hd + n][4 * g + 2] * qs, acc[0][3 * hd + n][4 * g + 3] * qs);
  }
}
DEVI void mlakv_unit(PP p, int l, int mt, int head, u16* sm) {
  const int lane = TIDX & 63, wid = TIDX >> 6, c = lane & 31, hh = lane >> 5;
  f32x16 acc[1][4]; zero_acc(acc);
  XRowLin xr{p->P + (size_t)mt * 256 * NINP + O_KVLAT, (size_t)NINP};
  float ss = 0.f;
  GemmKV::kloop<XRowLin, true>(acc, xr, p->Wt_kvb + (size_t)l * 1024 * 256 + (size_t)head * 128 * 256, 256, 256, sm, &ss);
  const int row = mt * 256 + wid * 32 + c;
  ss = sum32(ss);
  const float rstd = rsqrtf(ss * (1.f / 256.f) + EPS);
  f32x16 kr;
  const u16* krp = p->P + (size_t)row * NINP + O_KROPE + 4 * hh;
#pragma unroll
  for (int g = 0; g < 4; ++g) { const u32x2 t = *reinterpret_cast<const u32x2*>(krp + 8 * g);
    kr[4 * g] = bflo(t.x); kr[4 * g + 1] = bfhi(t.x); kr[4 * g + 2] = bflo(t.y); kr[4 * g + 3] = bfhi(t.y); }
  float s2 = 0.f;
#pragma unroll
  for (int n = 0; n < 4; ++n)
#pragma unroll
    for (int i = 0; i < 16; ++i) { acc[0][n][i] *= rstd; if (n < 2) s2 += acc[0][n][i] * acc[0][n][i]; }
#pragma unroll
  for (int i = 0; i < 16; ++i) s2 += kr[i] * kr[i];
  s2 = sum32(s2);
  const float r2 = rsqrtf(s2 * (1.f / 96.f) + EPS);
  const float* kw = p->kn_w + l * 96;
#pragma unroll
  for (int g = 0; g < 4; ++g) {
    const f32x4 w0 = *reinterpret_cast<const f32x4*>(kw + 8 * g + 4 * hh), w1 = *reinterpret_cast<const f32x4*>(kw + 32 + 8 * g + 4 * hh), w2 = *reinterpret_cast<const f32x4*>(kw + 64 + 8 * g + 4 * hh);
#pragma unroll
    for (int j = 0; j < 4; ++j) { acc[0][0][4 * g + j] *= r2 * w0[j]; acc[0][1][4 * g + j] *= r2 * w1[j]; kr[4 * g + j] *= r2 * w2[j]; }
  }
  int b, key;
  if (row < TL) { b = row >> 13; key = CTXL + (row & (SEQ - 1)); rope_sub(kr, p->rope, row & (SEQ - 1), hh); }
  else { b = (row - TL) >> 8; key = (row - TL) & (CTXL - 1); }
  u16* dst = p->K + ((size_t)b * KEYS + key) * 768 + head * 96;
#pragma unroll
  for (int g = 0; g < 4; ++g) {
    st_bf4(dst + 8 * g + 4 * hh, acc[0][0][4 * g], acc[0][0][4 * g + 1], acc[0][0][4 * g + 2], acc[0][0][4 * g + 3]);
    st_bf4(dst + 32 + 8 * g + 4 * hh, acc[0][1][4 * g], acc[0][1][4 * g + 1], acc[0][1][4 * g + 2], acc[0][1][4 * g + 3]);
    st_bf4(dst + 64 + 8 * g + 4 * hh, kr[4 * g], kr[4 * g + 1], kr[4 * g + 2], kr[4 * g + 3]);
  }
  const int kpos = (key & ~15) | perm16(key & 15);
  u16* vdst = p->Vt + ((size_t)(b * 8 + head) * 64) * KEYS + kpos;
#pragma unroll
  for (int n = 0; n < 2; ++n)
#pragma unroll
    for (int i = 0; i < 16; ++i) vdst[(size_t)(32 * n + crow(i, hh)) * KEYS] = f2bf(acc[0][2 + n][i]);
}

constexpr int AK_LD = 104, AV_LD = 72, ATT_STAGE = 64 * AK_LD + 64 * AV_LD;
template <bool FAST>
DEVI void attn_unit(PP p, int b, int head, int q0row, int nkeys, u16* sm) {
  const int tid = TIDX, lane = tid & 63, wid = tid >> 6, c = lane & 31, hh = lane >> 5;
  const int row = q0row + wid * 32 + c;
  bf16x8 qf[6];
#pragma unroll
  for (int s = 0; s < 6; ++s) qf[s] = ld_frag(p->Q + (size_t)row * 768 + head * 96 + s * 16 + hh * 8);
  f32x16 o[2], negm;
#pragma unroll
  for (int i = 0; i < 16; ++i) { o[0][i] = 0.f; o[1][i] = 0.f; negm[i] = 0.f; }
  float lsum = 0.f;
  const u16* Kg = p->K + (size_t)b * KEYS * 768 + head * 96;
  const u16* Vg = p->Vt + (size_t)(b * 8 + head) * 64 * KEYS;
  const int id1 = 512 + tid;
  const bool s1k = id1 < 768;
  const u16* g0 = Kg + (size_t)(tid / 12) * 768 + (tid % 12) * 8;
  const int l0 = (tid / 12) * AK_LD + (tid % 12) * 8;
  const u16* g1 = s1k ? Kg + (size_t)(id1 / 12) * 768 + (id1 % 12) * 8 : Vg + (size_t)((id1 - 768) >> 3) * KEYS + ((id1 - 768) & 7) * 8;
  const int l1 = s1k ? (id1 / 12) * AK_LD + (id1 % 12) * 8 : 64 * AK_LD + ((id1 - 768) >> 3) * AV_LD + ((id1 - 768) & 7) * 8;
  const size_t st1 = s1k ? (size_t)64 * 768 : 64;
  const int id2 = 256 + tid;
  const u16* g2 = Vg + (size_t)(id2 >> 3) * KEYS + (id2 & 7) * 8;
  const int l2 = 64 * AK_LD + (id2 >> 3) * AV_LD + (id2 & 7) * 8;
  u32x4 r0, r1, r2;
  auto gload = [&](int j) {
    r0 = *reinterpret_cast<const u32x4*>(g0 + (size_t)j * 64 * 768);
    r1 = *reinterpret_cast<const u32x4*>(g1 + (size_t)j * st1);
    if (tid < 256) r2 = *reinterpret_cast<const u32x4*>(g2 + (size_t)j * 64);
  };
  auto swrite = [&](int st) {
    u16* s = sm + st * ATT_STAGE;
    *reinterpret_cast<u32x4*>(s + l0) = r0; *reinterpret_cast<u32x4*>(s + l1) = r1;
    if (tid < 256) *reinterpret_cast<u32x4*>(s + l2) = r2;
  };
  const int NT = nkeys / 64;
  __syncthreads();
  gload(0); swrite(0); __syncthreads();
  for (int j = 0; j < NT; ++j) {
    if (j + 1 < NT) gload(j + 1);
    const u16* Ks = sm + (j & 1) * ATT_STAGE; const u16* Vs = Ks + 64 * AK_LD;
    f32x16 s0 = negm, s1 = negm;
    {
      const u16* k0p = Ks + c * AK_LD + hh * 8; const u16* k1p = Ks + (32 + c) * AK_LD + hh * 8;
      bf16x8 fa[4], fb[4];
      fa[0] = ld_frag(k0p); fa[1] = ld_frag(k1p); fa[2] = ld_frag(k0p + 16); fa[3] = ld_frag(k1p + 16);
      fb[0] = ld_frag(k0p + 32); fb[1] = ld_frag(k1p + 32); fb[2] = ld_frag(k0p + 48); fb[3] = ld_frag(k1p + 48);
      __builtin_amdgcn_sched_barrier(0);
      s0 = mfma(fa[0], qf[0], s0); s1 = mfma(fa[1], qf[0], s1); s0 = mfma(fa[2], qf[1], s0); s1 = mfma(fa[3], qf[1], s1);
      __builtin_amdgcn_sched_barrier(0);
      fa[0] = ld_frag(k0p + 64); fa[1] = ld_frag(k1p + 64); fa[2] = ld_frag(k0p + 80); fa[3] = ld_frag(k1p + 80);
      __builtin_amdgcn_sched_barrier(0);
      s0 = mfma(fb[0], qf[2], s0); s1 = mfma(fb[1], qf[2], s1); s0 = mfma(fb[2], qf[3], s0); s1 = mfma(fb[3], qf[3], s1);
      __builtin_amdgcn_sched_barrier(0);
      s0 = mfma(fa[0], qf[4], s0); s1 = mfma(fa[1], qf[4], s1); s0 = mfma(fa[2], qf[5], s0); s1 = mfma(fa[3], qf[5], s1);
    }
    if (!FAST) {
      float pmax = fmaxf(s0[0], s1[0]);
#pragma unroll
      for (int i = 1; i < 16; ++i) pmax = fmaxf(pmax, fmaxf(s0[i], s1[i]));
      pmax = max32(pmax);
      if (!__all(pmax <= 8.f)) {
        const float d = fmaxf(pmax, 0.f), al = __builtin_amdgcn_exp2f(-d);
        lsum *= al;
#pragma unroll
        for (int i = 0; i < 16; ++i) { negm[i] -= d; o[0][i] *= al; o[1][i] *= al; s0[i] -= d; s1[i] -= d; }
      }
    }
    f32x2 ps2 = {0.f, 0.f};
#pragma unroll
    for (int i = 0; i < 16; ++i) { s0[i] = __builtin_amdgcn_exp2f(s0[i]); s1[i] = __builtin_amdgcn_exp2f(s1[i]); ps2 += (f32x2){s0[i], s1[i]}; }
    lsum += ps2[0] + ps2[1];
#pragma unroll
    for (int n = 0; n < 2; ++n)
#pragma unroll
      for (int s2 = 0; s2 < 2; ++s2) {
        const f32x16& sv = n ? s1 : s0;
        u32x4 pk = {cvtpk(sv[8 * s2], sv[8 * s2 + 1]), cvtpk(sv[8 * s2 + 2], sv[8 * s2 + 3]), cvtpk(sv[8 * s2 + 4], sv[8 * s2 + 5]), cvtpk(sv[8 * s2 + 6], sv[8 * s2 + 7])};
        const bf16x8 pb = __builtin_bit_cast(bf16x8, pk);
#pragma unroll
        for (int dvt = 0; dvt < 2; ++dvt) {
          const bf16x8 va = ld_frag(Vs + (dvt * 32 + c) * AV_LD + (2 * n + s2) * 16 + hh * 8);
          o[dvt] = mfma(va, pb, o[dvt]);
        }
      }
    if (j + 1 < NT) swrite((j + 1) & 1);
    __syncthreads();
  }
  lsum = sum32(lsum);
  const float inv = 1.f / lsum;
  u16* dst = p->yb + (size_t)row * 512 + head * 64;
#pragma unroll
  for (int dvt = 0; dvt < 2; ++dvt)
#pragma unroll
    for (int g = 0; g < 4; ++g) st_bf4(dst + dvt * 32 + 8 * g + 4 * hh, o[dvt][4 * g] * inv, o[dvt][4 * g + 1] * inv, o[dvt][4 * g + 2] * inv, o[dvt][4 * g + 3] * inv);
}

DEVI float scan_sum(float v, int lane) {
#pragma unroll
  for (int o = 1; o < 64; o <<= 1) { const float t = shfl_up_f(v, o, lane); if (lane >= o) v += t; }
  return v;
}
DEVI float scan_max(float v, int lane) {
#pragma unroll
  for (int o = 1; o < 64; o <<= 1) { const float t = shfl_up_f(v, o, lane); if (lane >= o) v = fmaxf(v, t); }
  return v;
}
DEVI float ret_lg2(int head, int dir) { const int hx = dir ? 7 - head : head; return log2f(1.f - exp2f(-5.f - (float)hx)); }
DEVI int chain_step(int seg, int ck, int dir) { return dir ? (seg ? 1 - ck : 65 - ck) : (seg ? ck : 2 + ck); }

struct MlGate { float b0, b1, u0, u1, pm0, pm1, bl, umax; int i0, i1; };
DEVI MlGate ml_gates(PP p, int row0, int head, int dir, int lane) {
  MlGate g;
  g.i0 = dir ? 127 - lane : lane; g.i1 = dir ? 63 - lane : 64 + lane;
  const float* ga = p->gates + (size_t)(row0 + g.i0) * 32 + dir * 16 + head;
  const float* gb = p->gates + (size_t)(row0 + g.i1) * 32 + dir * 16 + head;
  const float ig0 = ga[0], fg0 = ga[8], ig1 = gb[0], fg1 = gb[8];
  const float lf0 = fminf(fg0, 0.f) - log1pf(__expf(-fabsf(fg0))), lf1 = fminf(fg1, 0.f) - log1pf(__expf(-fabsf(fg1)));
  g.b0 = scan_sum(lf0, lane); const float t0 = lane63(g.b0);
  g.b1 = scan_sum(lf1, lane) + t0; g.bl = lane63(g.b1);
  g.u0 = ig0 - g.b0; g.u1 = ig1 - g.b1;
  g.pm0 = scan_max(g.u0, lane); const float m0 = lane63(g.pm0);
  g.pm1 = fmaxf(scan_max(g.u1, lane), m0); g.umax = lane63(g.pm1);
  return g;
}

DEVI void conv16_load(PP p, int rowbase, int L, int ti, int col0, u32x4 (&ta)[5], u32x4 (&tb)[5]) {
#pragma unroll
  for (int j = 0; j < 5; ++j) {
    const int tj = ti + j - 2, tc = tj < 0 ? 0 : (tj >= L ? L - 1 : tj);
    const u16* src = p->P + (size_t)(rowbase + tc) * NINP + O_QK + col0;
    ta[j] = *reinterpret_cast<const u32x4*>(src); tb[j] = *reinterpret_cast<const u32x4*>(src + 8);
  }
}
DEVI void conv16_calc(PP p, int l, int L, int ti, int col0, const u32x4 (&ta)[5], const u32x4 (&tb)[5], float (&o)[16]) {
  const float* cw = p->conv_w + (size_t)l * 5 * 1024 + col0; const float* cb = p->conv_b + l * 1024 + col0;
#pragma unroll
  for (int k = 0; k < 16; k += 4) { const f32x4 b = *reinterpret_cast<const f32x4*>(cb + k); o[k] = b[0]; o[k + 1] = b[1]; o[k + 2] = b[2]; o[k + 3] = b[3]; }
#pragma unroll
  for (int j = 0; j < 5; ++j) {
    const int tj = ti + j - 2;
    const bool ok = tj >= 0 && tj < L;
    const u32x4 a = ok ? ta[j] : (u32x4){0u, 0u, 0u, 0u}, b = ok ? tb[j] : (u32x4){0u, 0u, 0u, 0u};
#pragma unroll
    for (int k = 0; k < 4; ++k) {
      const f32x4 w = *reinterpret_cast<const f32x4*>(cw + j * 1024 + 4 * k);
      const unsigned lo = k < 2 ? a[2 * k] : b[2 * k - 4], hi = k < 2 ? a[2 * k + 1] : b[2 * k - 3];
      o[4 * k] += w[0] * bflo(lo); o[4 * k + 1] += w[1] * bfhi(lo); o[4 * k + 2] += w[2] * bflo(hi); o[4 * k + 3] += w[3] * bfhi(hi);
    }
  }
#pragma unroll
  for (int k = 0; k < 16; ++k) o[k] = siluf_(o[k]);
}
DEVI void conv16(PP p, int l, int rowbase, int L, int ti, int col0, float (&o)[16]) {
  u32x4 ta[5], tb[5];
  conv16_load(p, rowbase, L, ti, col0, ta, tb);
  conv16_calc(p, l, L, ti, col0, ta, tb, o);
}
DEVI void unpack16(const u32x4 a, const u32x4 b, float (&o)[16]) {
#pragma unroll
  for (int k = 0; k < 4; ++k) { o[2 * k] = bflo(a[k]); o[2 * k + 1] = bfhi(a[k]); o[8 + 2 * k] = bflo(b[k]); o[8 + 2 * k + 1] = bfhi(b[k]); }
}
DEVI void ld16(const u16* src, float (&o)[16]) {
  const u32x4 a = *reinterpret_cast<const u32x4*>(src), b = *reinterpret_cast<const u32x4*>(src + 8);
#pragma unroll
  for (int k = 0; k < 4; ++k) { o[2 * k] = bflo(a[k]); o[2 * k + 1] = bfhi(a[k]); o[8 + 2 * k] = bflo(b[k]); o[8 + 2 * k + 1] = bfhi(b[k]); }
}
DEVI void rope16(float (&o)[16], const float* rope, int pos) {
#pragma unroll
  for (int f = 0; f < 8; ++f) { const float cs = rope[(pos * 8 + f) * 2], sn = rope[(pos * 8 + f) * 2 + 1];
    const float x1 = o[f], x2 = o[8 + f]; o[f] = x1 * cs - x2 * sn; o[8 + f] = x1 * sn + x2 * cs; }
}
DEVI void ret_qk16(PP p, int row, int col0, int part, bool latent, float scale, float (&o)[16]) {
  ld16(p->P + (size_t)row * NINP + col0 + part * 16, o);
  if (latent) { const int t = row & (SEQ - 1); rope16(o, p->rope, part ? (t & 63) : (t >> 6)); }
#pragma unroll
  for (int k = 0; k < 16; ++k) o[k] *= scale;
}

constexpr int VT_LD = 136;
struct ScanAPre { u32x4 v0, v1; u32x4 ta[5], tb[5]; };
template <bool ML>
DEVI void scan_a_preload(PP p, int b, int head, int seg, int ck, ScanAPre& pre) {
  const int tid = TIDX, i = tid >> 2, part = tid & 3;
  const int L = seg ? CTXL : SEQ, rowbase = seg ? TL + b * CTXL : b * SEQ, row0 = rowbase + ck * 128;
  const u16* vs = p->P + (size_t)(row0 + i) * NINP + (ML ? O_V : O_RV) + head * 64 + part * 16;
  pre.v0 = *reinterpret_cast<const u32x4*>(vs); pre.v1 = *reinterpret_cast<const u32x4*>(vs + 8);
  if (ML) conv16_load(p, rowbase, L, ck * 128 + i, 512 + head * 64 + part * 16, pre.ta, pre.tb);
  else if (part < 2) { const u16* ks = p->P + (size_t)(row0 + i) * NINP + O_RK + head * 32 + part * 16;
    pre.ta[0] = *reinterpret_cast<const u32x4*>(ks); pre.tb[0] = *reinterpret_cast<const u32x4*>(ks + 8); }
}
template <bool ML, int STAGE>
DEVI void scan_a_stage(PP p, int l, int b, int head, int seg, int ck, char* smem, const ScanAPre& pre) {
  constexpr int DK = ML ? 64 : 32;
  u16* Vt = reinterpret_cast<u16*>(smem);
  u16* Kt = Vt + 64 * VT_LD;
  float* wg = reinterpret_cast<float*>(Kt + 2 * DK * VT_LD);
  const int tid = TIDX, lane = tid & 63, wid = tid >> 6, c = lane & 31, hh = lane >> 5;
  const int L = seg ? CTXL : SEQ, rowbase = seg ? TL + b * CTXL : b * SEQ, row0 = rowbase + ck * 128;
  const int chain0 = (b * 8 + head) * 2;
  if constexpr (STAGE == 0) {
  if (ML) {
    if (wid < 2) { const int dir = wid; const MlGate g = ml_gates(p, row0, head, dir, lane);
      wg[dir * 128 + g.i0] = __expf(g.u0 - g.umax); wg[dir * 128 + g.i1] = __expf(g.u1 - g.umax);
      if (lane == 0) { float* dm = p->dM + ((size_t)(chain0 + dir) * NCHUNK + chain_step(seg, ck, dir)) * 2; dm[0] = g.bl; dm[1] = g.bl + g.umax; }
      float* gq = p->gq + ((size_t)(chain0 + dir) * NCHUNK + chain_step(seg, ck, dir)) * 512;
      *reinterpret_cast<f32x4*>(gq + g.i0 * 4) = (f32x4){g.b0, g.u0, g.pm0, 0.f}; *reinterpret_cast<f32x4*>(gq + g.i1 * 4) = (f32x4){g.b1, g.u1, g.pm1, 0.f}; }
  } else {
    if (tid < 256) { const int dir = tid >> 7, i = tid & 127; wg[tid] = exp2f(ret_lg2(head, dir) * (float)(dir ? i : 127 - i)); }
  }
  }
  if constexpr (STAGE == 1) {
  {
    const int i = tid >> 2, part = tid & 3, pos = (i & ~15) | perm16(i & 15);
    float v[16];
    unpack16(pre.v0, pre.v1, v);
#pragma unroll
    for (int k = 0; k < 16; ++k) Vt[(part * 16 + k) * VT_LD + pos] = f2bf(v[k]);
    if (ML || part < 2) {
      float kv[16];
      if (ML) { conv16_calc(p, l, L, ck * 128 + i, 512 + head * 64 + part * 16, pre.ta, pre.tb, kv);
#pragma unroll
        for (int k = 0; k < 16; ++k) kv[k] *= 0.125f;
        u32x4 ka = {cvtpk(kv[0], kv[1]), cvtpk(kv[2], kv[3]), cvtpk(kv[4], kv[5]), cvtpk(kv[6], kv[7])}, kb = {cvtpk(kv[8], kv[9]), cvtpk(kv[10], kv[11]), cvtpk(kv[12], kv[13]), cvtpk(kv[14], kv[15])};
        u16* kc = p->Kc + (size_t)(row0 + i) * 512 + head * 64 + part * 16;
        *reinterpret_cast<u32x4*>(kc) = ka; *reinterpret_cast<u32x4*>(kc + 8) = kb;
      } else {
        unpack16(pre.ta[0], pre.tb[0], kv);
        if (seg == 0) { const int t = (row0 + i) & (SEQ - 1); rope16(kv, p->rope, part ? (t & 63) : (t >> 6)); }
#pragma unroll
        for (int k = 0; k < 16; ++k) kv[k] *= 0.17677669529663687f;
      }
      const float w0 = wg[i], w1 = wg[128 + i];
#pragma unroll
      for (int k = 0; k < 16; ++k) { Kt[(part * 16 + k) * VT_LD + pos] = f2bf(kv[k] * w0); Kt[(DK + part * 16 + k) * VT_LD + pos] = f2bf(kv[k] * w1); }
    }
  }
  }
  if constexpr (STAGE == 2) {
  {
    const int dir = wid >> 2, vt = (wid >> 1) & 1, dt = wid & 1;
    const int j = chain_step(seg, ck, dir);
    if (ML || dt == 0) {
      f32x16 acc;
#pragma unroll
      for (int i = 0; i < 16; ++i) acc[i] = 0.f;
#pragma unroll
      for (int ks = 0; ks < 8; ++ks) acc = mfma(ld_frag(Vt + (vt * 32 + c) * VT_LD + ks * 16 + hh * 8), ld_frag(Kt + (dir * DK + dt * 32 + c) * VT_LD + ks * 16 + hh * 8), acc);
      float* dst = (ML ? p->dC : p->dR) + ((size_t)(chain0 + dir) * NCHUNK + j) * 64 * DK + dt * 32 + c;
#pragma unroll
      for (int i = 0; i < 16; ++i) dst[(size_t)(vt * 32 + crow(i, hh)) * DK] = acc[i];
    }
  }
  if (ML && tid < 128) {
    const int dir = tid >> 6, d = tid & 63;
    float s = 0.f;
#pragma unroll 4
    for (int i = 0; i < 16; ++i) { const u32x4 t = *reinterpret_cast<const u32x4*>(Kt + (dir * DK + d) * VT_LD + i * 8);
      s += bflo(t[0]) + bfhi(t[0]) + bflo(t[1]) + bfhi(t[1]) + bflo(t[2]) + bfhi(t[2]) + bflo(t[3]) + bfhi(t[3]); }
    p->dN[((size_t)(chain0 + dir) * NCHUNK + chain_step(seg, ck, dir)) * 64 + d] = s;
  }
  }
}
DEVI void scan_a_pair(PP p, int l, int b, int head, int seg, int ck, char* smem) {
  char* smB = smem + 56 * 1024;
  ScanAPre pm, pr;
  scan_a_preload<true>(p, b, head, seg, ck, pm); scan_a_preload<false>(p, b, head, seg, ck, pr);
  __syncthreads();
  scan_a_stage<true, 0>(p, l, b, head, seg, ck, smem, pm); scan_a_stage<false, 0>(p, l, b, head, seg, ck, smB, pr);
  __syncthreads();
  scan_a_stage<true, 1>(p, l, b, head, seg, ck, smem, pm); scan_a_stage<false, 1>(p, l, b, head, seg, ck, smB, pr);
  __syncthreads();
  scan_a_stage<true, 2>(p, l, b, head, seg, ck, smem, pm); scan_a_stage<false, 2>(p, l, b, head, seg, ck, smB, pr);
}
DEVI void carry_ml(PP p, int chain) {
  const int tid = TIDX;
  float C[8], n = 0.f, m = 0.f;
#pragma unroll
  for (int k = 0; k < 8; ++k) C[k] = 0.f;
  const size_t base0 = (size_t)chain * NCHUNK;
  f32x4 d0 = *reinterpret_cast<const f32x4*>(p->dC + base0 * 4096 + tid * 8), d1 = *reinterpret_cast<const f32x4*>(p->dC + base0 * 4096 + tid * 8 + 4);
  float bl = p->dM[base0 * 2], ml = p->dM[base0 * 2 + 1], dn = tid < 64 ? p->dN[base0 * 64 + tid] : 0.f;
  for (int j = 0; j < NCHUNK; ++j) {
    const size_t base = base0 + j;
    const size_t nb = base0 + (j + 1 < NCHUNK ? j + 1 : j);
    const f32x4 e0 = *reinterpret_cast<const f32x4*>(p->dC + nb * 4096 + tid * 8), e1 = *reinterpret_cast<const f32x4*>(p->dC + nb * 4096 + tid * 8 + 4);
    const float nbl = p->dM[nb * 2], nml = p->dM[nb * 2 + 1], ndn = tid < 64 ? p->dN[nb * 64 + tid] : 0.f;
    u32x4 cb = {cvtpk(C[0], C[1]), cvtpk(C[2], C[3]), cvtpk(C[4], C[5]), cvtpk(C[6], C[7])};
    *reinterpret_cast<u32x4*>(p->Cin + base * 4096 + tid * 8) = cb;
    if (tid < 64) p->nin[base * 64 + tid] = n;
    if (tid == 0) p->min_[base] = m;
    const float mn = fmaxf(bl + m, ml), a = __expf(bl + m - mn), bb = __expf(ml - mn);
#pragma unroll
    for (int k = 0; k < 4; ++k) { C[k] = a * C[k] + bb * d0[k]; C[4 + k] = a * C[4 + k] + bb * d1[k]; }
    n = a * n + bb * dn;
    m = mn;
    d0 = e0; d1 = e1; bl = nbl; ml = nml; dn = ndn;
  }
}
DEVI void carry_ret(PP p, int chain) {
  const int tid = TIDX, head = (chain >> 1) & 7, dir = chain & 1;
  const float cd = exp2f(128.f * ret_lg2(head, dir));
  float R[4] = {0.f, 0.f, 0.f, 0.f};
  const size_t base0 = (size_t)chain * NCHUNK;
  f32x4 d = *reinterpret_cast<const f32x4*>(p->dR + base0 * 2048 + tid * 4);
  for (int j = 0; j < NCHUNK; ++j) {
    const size_t base = base0 + j, nb = base0 + (j + 1 < NCHUNK ? j + 1 : j);
    const f32x4 e = *reinterpret_cast<const f32x4*>(p->dR + nb * 2048 + tid * 4);
    u32x2 rb = {cvtpk(R[0], R[1]), cvtpk(R[2], R[3])};
    *reinterpret_cast<u32x2*>(p->Rin + base * 2048 + tid * 4) = rb;
#pragma unroll
    for (int k = 0; k < 4; ++k) R[k] = cd * R[k] + d[k];
    d = e;
  }
}

DEVI void carry_pair(PP p, int chain) {
  const int tid = TIDX, head = (chain >> 1) & 7, dir = chain & 1;
  const float cd = exp2f(128.f * ret_lg2(head, dir));
  float C[8], n = 0.f, m = 0.f;
  float R[4] = {0.f, 0.f, 0.f, 0.f};
#pragma unroll
  for (int k = 0; k < 8; ++k) C[k] = 0.f;
  const size_t base0 = (size_t)chain * NCHUNK;
  f32x4 D0[3], D1[3], DR[3]; float BL[3], ML[3], DN[3];
#define CP_LOAD(u_, s_) do { const size_t nb_ = base0 + ((s_) < NCHUNK ? (s_) : NCHUNK - 1); \
    D0[u_] = *reinterpret_cast<const f32x4*>(p->dC + nb_ * 4096 + tid * 8); D1[u_] = *reinterpret_cast<const f32x4*>(p->dC + nb_ * 4096 + tid * 8 + 4); \
    DR[u_] = *reinterpret_cast<const f32x4*>(p->dR + nb_ * 2048 + tid * 4); \
    BL[u_] = p->dM[nb_ * 2]; ML[u_] = p->dM[nb_ * 2 + 1]; DN[u_] = tid < 64 ? p->dN[nb_ * 64 + tid] : 0.f; } while (0)
  CP_LOAD(0, 0); CP_LOAD(1, 1); CP_LOAD(2, 2);
  static_assert(NCHUNK % 3 == 0, "three-step ring");
  for (int j = 0; j < NCHUNK; j += 3) {
#pragma unroll
    for (int u = 0; u < 3; ++u) {
      const size_t base = base0 + j + u;
      u32x4 cb = {cvtpk(C[0], C[1]), cvtpk(C[2], C[3]), cvtpk(C[4], C[5]), cvtpk(C[6], C[7])};
      *reinterpret_cast<u32x4*>(p->Cin + base * 4096 + tid * 8) = cb;
      if (tid < 64) p->nin[base * 64 + tid] = n;
      if (tid == 0) p->min_[base] = m;
      u32x2 rb = {cvtpk(R[0], R[1]), cvtpk(R[2], R[3])};
      *reinterpret_cast<u32x2*>(p->Rin + base * 2048 + tid * 4) = rb;
      const float bl = BL[u], ml = ML[u];
      const float mn = fmaxf(bl + m, ml), a = __expf(bl + m - mn), bb = __expf(ml - mn);
#pragma unroll
      for (int k = 0; k < 4; ++k) { C[k] = a * C[k] + bb * D0[u][k]; C[4 + k] = a * C[4 + k] + bb * D1[u][k]; }
      n = a * n + bb * DN[u];
      m = mn;
#pragma unroll
      for (int k = 0; k < 4; ++k) R[k] = cd * R[k] + DR[u][k];
      CP_LOAD(u, j + u + 3);
    }
  }
#undef CP_LOAD
}

DEVI int scan_ticket_item(int l, int u) {
  const bool lastl = (l == DEPTH - 1);
  const int nsc = 2 * NB * 8 * (lastl ? 64 : NCHUNK);
  if (lastl) return u < nsc ? u : -1;
  const int total = ((nsc + 8) / 9) * 11;
  if (u >= total) return -1;
  const int g = u / 11, r = u - g * 11;
  if (r >= 9) return -1;
  const int it = g * 9 + r;
  return it < nsc ? it : -1;
}
struct ScanCPre { u32x4 v0, v1, k0, k1, c0, c1; u32x4 ta[5], tb[5]; };
DEVI void scan_c_decode(int l, int it, bool& ml, int& b, int& head, int& seg, int& ck) {
  const int per = (l == DEPTH - 1) ? 64 : NCHUNK;
  const int NSC = NB * 8 * per;
  int v = it; ml = v < NSC; if (!ml) v -= NSC;
  const int bh = v / per, cc = v % per;
  if (per == 64) { seg = 0; ck = cc; } else { seg = cc < 2 ? 1 : 0; ck = seg ? cc : cc - 2; }
  b = bh >> 3; head = bh & 7;
}
DEVI void scan_c_preload(PP p, int l, int it, ScanCPre& pre) {
  bool ml; int b, head, seg, ck; scan_c_decode(l, it, ml, b, head, seg, ck);
  const int tid = TIDX, i = tid >> 2, part = tid & 3;
  const int L = seg ? CTXL : SEQ, rowbase = seg ? TL + b * CTXL : b * SEQ, row0 = rowbase + ck * 128;
  const int chain0 = (b * 8 + head) * 2;
  const u16* vs = p->P + (size_t)(row0 + i) * NINP + (ml ? O_V : O_RV) + head * 64 + part * 16;
  pre.v0 = *reinterpret_cast<const u32x4*>(vs); pre.v1 = *reinterpret_cast<const u32x4*>(vs + 8);
  if (ml) {
    conv16_load(p, rowbase, L, ck * 128 + i, head * 64 + part * 16, pre.ta, pre.tb);
    const u16* kc = p->Kc + (size_t)(row0 + i) * 512 + head * 64 + part * 16;
    pre.k0 = *reinterpret_cast<const u32x4*>(kc); pre.k1 = *reinterpret_cast<const u32x4*>(kc + 8);
#pragma unroll
    for (int h = 0; h < 2; ++h) {
      const size_t base = (size_t)(chain0 + h) * NCHUNK + chain_step(seg, ck, h);
      const u32x4 t = *reinterpret_cast<const u32x4*>(p->Cin + base * 4096 + (tid >> 3) * 64 + (tid & 7) * 8);
      if (h == 0) pre.c0 = t; else pre.c1 = t;
    }
  } else {
    const bool isk = part >= 2; const int pp = part & 1;
    const u16* qs = p->P + (size_t)(row0 + i) * NINP + (isk ? O_RK : O_RQ) + head * 32 + pp * 16;
    pre.ta[0] = *reinterpret_cast<const u32x4*>(qs); pre.tb[0] = *reinterpret_cast<const u32x4*>(qs + 8);
    { const int dir = tid >> 8, r = tid & 255;
      const size_t base = (size_t)(chain0 + dir) * NCHUNK + chain_step(seg, ck, dir);
      pre.c0 = *reinterpret_cast<const u32x4*>(p->Rin + base * 2048 + (r >> 2) * 32 + (r & 3) * 8); }
  }
}

template <bool ML>
DEVI void scan_c_unit(PP p, int l, int b, int head, int seg, int ck, char* smem, ScanCPre& pre, int nxt_ticket, int& nit) {
  constexpr int DK = ML ? 64 : 32, QLD = DK + 8;
  u16* Qs = reinterpret_cast<u16*>(smem);
  u16* Ks = Qs + 128 * QLD;
  u16* Vt = Ks + 128 * QLD;
  u16* Cs = Vt + 64 * VT_LD;
  float* fl = reinterpret_cast<float*>(Cs + 2 * 64 * QLD);
  float* alpha = fl;
  float* beta = fl + 256;
  float* inter = fl + 512;
  float* lowb = fl + 768;
  float* nv = fl + 1024;
  float* hbuf = fl + 1152;
  const int tid = TIDX, lane = tid & 63, wid = tid >> 6, c = lane & 31, hh = lane >> 5;
  const int L = seg ? CTXL : SEQ, rowbase = seg ? TL + b * CTXL : b * SEQ, row0 = rowbase + ck * 128;
  const int chain0 = (b * 8 + head) * 2;
  __syncthreads();
  if (ML && wid < 2) {
    const int dir = wid;
    const size_t base = (size_t)(chain0 + dir) * NCHUNK + chain_step(seg, ck, dir);
    MlGate g; g.i0 = dir ? 127 - lane : lane; g.i1 = dir ? 63 - lane : 64 + lane;
    { const f32x4 q0 = *reinterpret_cast<const f32x4*>(p->gq + base * 512 + g.i0 * 4), q1 = *reinterpret_cast<const f32x4*>(p->gq + base * 512 + g.i1 * 4);
      g.b0 = q0[0]; g.u0 = q0[1]; g.pm0 = q0[2]; g.b1 = q1[0]; g.u1 = q1[1]; g.pm1 = q1[2]; }
    const float m_in = p->min_[base];
    { const float a = g.b0 + m_in, mt = fmaxf(a, g.b0 + g.pm0); const int i = g.i0;
      alpha[dir * 128 + i] = (g.b0 - mt) * LOG2E; beta[dir * 128 + i] = g.u0 * LOG2E; inter[dir * 128 + i] = __expf(a - mt); lowb[dir * 128 + i] = __expf(-mt); }
    { const float a = g.b1 + m_in, mt = fmaxf(a, g.b1 + g.pm1); const int i = g.i1;
      alpha[dir * 128 + i] = (g.b1 - mt) * LOG2E; beta[dir * 128 + i] = g.u1 * LOG2E; inter[dir * 128 + i] = __expf(a - mt); lowb[dir * 128 + i] = __expf(-mt); }
    nv[dir * 64 + lane] = p->nin[base * 64 + lane];
  }
  {
    const int i = tid >> 2, part = tid & 3, pos = (i & ~15) | perm16(i & 15);
    float v[16];
    unpack16(pre.v0, pre.v1, v);
#pragma unroll
    for (int k = 0; k < 16; ++k) Vt[(part * 16 + k) * VT_LD + pos] = f2bf(v[k]);
    if (ML) {
      conv16_calc(p, l, L, ck * 128 + i, head * 64 + part * 16, pre.ta, pre.tb, v);
      u32x4 a = {cvtpk(v[0], v[1]), cvtpk(v[2], v[3]), cvtpk(v[4], v[5]), cvtpk(v[6], v[7])}, bq = {cvtpk(v[8], v[9]), cvtpk(v[10], v[11]), cvtpk(v[12], v[13]), cvtpk(v[14], v[15])};
      *reinterpret_cast<u32x4*>(Qs + i * QLD + part * 16) = a; *reinterpret_cast<u32x4*>(Qs + i * QLD + part * 16 + 8) = bq;
      *reinterpret_cast<u32x4*>(Ks + i * QLD + part * 16) = pre.k0; *reinterpret_cast<u32x4*>(Ks + i * QLD + part * 16 + 8) = pre.k1;
      *reinterpret_cast<u32x4*>(Cs + (0 * 64 + (tid >> 3)) * QLD + (tid & 7) * 8) = pre.c0;
      *reinterpret_cast<u32x4*>(Cs + (1 * 64 + (tid >> 3)) * QLD + (tid & 7) * 8) = pre.c1;
    } else {
      const bool isk = part >= 2; const int pp = part & 1;
      unpack16(pre.ta[0], pre.tb[0], v);
      if (seg == 0) { const int t_ = (row0 + i) & (SEQ - 1); rope16(v, p->rope, pp ? (t_ & 63) : (t_ >> 6)); }
      const float scl = isk ? 0.17677669529663687f : 1.f;
#pragma unroll
      for (int k = 0; k < 16; ++k) v[k] *= scl;
      u32x4 a = {cvtpk(v[0], v[1]), cvtpk(v[2], v[3]), cvtpk(v[4], v[5]), cvtpk(v[6], v[7])}, bq = {cvtpk(v[8], v[9]), cvtpk(v[10], v[11]), cvtpk(v[12], v[13]), cvtpk(v[14], v[15])};
      u16* dst = (isk ? Ks : Qs) + i * QLD + pp * 16;
      *reinterpret_cast<u32x4*>(dst) = a; *reinterpret_cast<u32x4*>(dst + 8) = bq;
      { const int d_ = tid >> 8, r = tid & 255;
        *reinterpret_cast<u32x4*>(Cs + (d_ * 64 + (r >> 2)) * QLD + (r & 3) * 8) = pre.c0; }
    }
  }
  __syncthreads();
  const int dir = wid >> 2, tq = wid & 3, t = tq * 32 + c;
  u32x2 gpre[2][4];
  if (dir == 0) {
    const u16* gp_ = p->P + (size_t)(row0 + t) * NINP + (ML ? O_OG : O_RG) + head * 64;
#pragma unroll
    for (int vt = 0; vt < 2; ++vt)
#pragma unroll
      for (int g = 0; g < 4; ++g) gpre[vt][g] = *reinterpret_cast<const u32x2*>(gp_ + vt * 32 + 8 * g + 4 * hh);
  }
  f32x16 num[2];
  {
    bf16x8 qf[DK / 16];
#pragma unroll
    for (int ks = 0; ks < DK / 16; ++ks) qf[ks] = ld_frag(Qs + t * QLD + ks * 16 + hh * 8);
#pragma unroll
    for (int i = 0; i < 16; ++i) { num[0][i] = 0.f; num[1][i] = 0.f; }
    float den = 0.f;
    const float lg2 = ML ? 0.f : ret_lg2(head, dir);
    const float al = ML ? alpha[dir * 128 + t] : 0.f;
    const int ss_lo = dir ? tq : 0, ss_hi = dir ? 3 : tq;
    for (int ss = ss_lo; ss <= ss_hi; ++ss) {
      f32x16 s;
#pragma unroll
      for (int i = 0; i < 16; ++i) s[i] = 0.f;
#pragma unroll
      for (int ks = 0; ks < DK / 16; ++ks) s = mfma(ld_frag(Ks + (ss * 32 + c) * QLD + ks * 16 + hh * 8), qf[ks], s);
#pragma unroll
      for (int g = 0; g < 4; ++g) {
        const int s0 = ss * 32 + 8 * g + 4 * hh;
        f32x4 bt;
        if (ML) bt = *reinterpret_cast<const f32x4*>(beta + dir * 128 + s0);
#pragma unroll
        for (int j = 0; j < 4; ++j) {
          const int si = s0 + j;
          const float w = ML ? __builtin_amdgcn_exp2f(al + bt[j]) : __builtin_amdgcn_exp2f(lg2 * (float)(dir ? si - t : t - si));
          const bool ok = dir ? (si >= t) : (si <= t);
          const float pv = ok ? s[4 * g + j] * w : 0.f;
          s[4 * g + j] = pv; den += pv;
        }
      }
#pragma unroll
      for (int s2 = 0; s2 < 2; ++s2) {
        u32x4 pk = {cvtpk(s[8 * s2], s[8 * s2 + 1]), cvtpk(s[8 * s2 + 2], s[8 * s2 + 3]), cvtpk(s[8 * s2 + 4], s[8 * s2 + 5]), cvtpk(s[8 * s2 + 6], s[8 * s2 + 7])};
        const bf16x8 pb = __builtin_bit_cast(bf16x8, pk);
#pragma unroll
        for (int vt = 0; vt < 2; ++vt) num[vt] = mfma(ld_frag(Vt + (vt * 32 + c) * VT_LD + ss * 32 + s2 * 16 + hh * 8), pb, num[vt]);
      }
    }
    f32x16 rq[2];
#pragma unroll
    for (int i = 0; i < 16; ++i) { rq[0][i] = 0.f; rq[1][i] = 0.f; }
#pragma unroll
    for (int vt = 0; vt < 2; ++vt)
#pragma unroll
      for (int ks = 0; ks < DK / 16; ++ks) rq[vt] = mfma(ld_frag(Cs + (dir * 64 + vt * 32 + c) * QLD + ks * 16 + hh * 8), qf[ks], rq[vt]);
    if (ML) {
      const float it = inter[dir * 128 + t];
      float nq = 0.f;
#pragma unroll
      for (int ks = 0; ks < DK / 16; ++ks) {
        const u32x4 qv = __builtin_bit_cast(u32x4, qf[ks]);
        const float* np_ = nv + dir * 64 + ks * 16 + hh * 8;
#pragma unroll
        for (int j = 0; j < 4; ++j) nq += bflo(qv[j]) * np_[2 * j] + bfhi(qv[j]) * np_[2 * j + 1];
      }
      nq = sum32(nq); den = sum32(den);
      const float dt = den + it * nq;
      const float inv = 1.f / fmaxf(fabsf(dt), lowb[dir * 128 + t]);
#pragma unroll
      for (int vt = 0; vt < 2; ++vt)
#pragma unroll
        for (int i = 0; i < 16; ++i) num[vt][i] = (num[vt][i] + it * rq[vt][i]) * inv;
    } else {
      const float xi = exp2f(lg2 * (float)(dir ? 128 - t : t + 1));
#pragma unroll
      for (int vt = 0; vt < 2; ++vt)
#pragma unroll
        for (int i = 0; i < 16; ++i) num[vt][i] += xi * rq[vt][i];
    }
    if (dir == 1) {
#pragma unroll
      for (int vt = 0; vt < 2; ++vt)
#pragma unroll
        for (int i = 0; i < 16; ++i) hbuf[t * 65 + vt * 32 + crow(i, hh)] = num[vt][i];
    }
  }
  if (tid == 0) reinterpret_cast<int*>(smem + LDS_BYTES - 128)[2] = nxt_ticket;
  f32x4 nwv[2][4];
  if (dir == 0) {
    const float* nwp = (ML ? p->ml_norm_w : p->ret_norm_w) + l * 512 + head * 64;
#pragma unroll
    for (int vt = 0; vt < 2; ++vt)
#pragma unroll
      for (int g = 0; g < 4; ++g) nwv[vt][g] = *reinterpret_cast<const f32x4*>(nwp + vt * 32 + 8 * g + 4 * hh);
  }
  __syncthreads();
  {
    nit = scan_ticket_item(l, reinterpret_cast<const int*>(smem + LDS_BYTES - 128)[2]);
    if (nit >= 0) scan_c_preload(p, l, nit, pre);
  }
  if (dir == 0) {
    float s1 = 0.f;
#pragma unroll
    for (int vt = 0; vt < 2; ++vt)
#pragma unroll
      for (int i = 0; i < 16; ++i) { num[vt][i] += hbuf[t * 65 + vt * 32 + crow(i, hh)]; s1 += num[vt][i]; }
    s1 = sum32(s1);
    const float mu = s1 * (1.f / 64.f);
    float s2 = 0.f;
#pragma unroll
    for (int vt = 0; vt < 2; ++vt)
#pragma unroll
      for (int i = 0; i < 16; ++i) { num[vt][i] -= mu; s2 += num[vt][i] * num[vt][i]; }
    s2 = sum32(s2);
    const float rstd = rsqrtf(s2 * (1.f / 64.f) + EPS);
    const int row = row0 + t;
    u16* dst = (ML ? p->ya : p->yc) + (size_t)row * 512 + head * 64;
#pragma unroll
    for (int vt = 0; vt < 2; ++vt)
#pragma unroll
      for (int g = 0; g < 4; ++g) {
        const int v0 = vt * 32 + 8 * g + 4 * hh;
        const f32x4 w = nwv[vt][g];
        const u32x2 gt = gpre[vt][g];
        const float gv[4] = {bflo(gt.x), bfhi(gt.x), bflo(gt.y), bfhi(gt.y)};
        float o[4];
#pragma unroll
        for (int j = 0; j < 4; ++j) { const float ga = ML ? sigmoidf_(gv[j]) : siluf_(gv[j]); o[j] = num[vt][4 * g + j] * rstd * w[j] * ga; }
        st_bf4(dst + v0, o[0], o[1], o[2], o[3]);
      }
  }
}

DEVI u16* zbuf(PP p, int br) { return br < 2 ? p->Q + (size_t)br * TT * DM : reinterpret_cast<u16*>(p->dC); }
DEVI void phase_merge(PP p, int l, char* smem) {
  {
    fg::MergeZOrder S; S.init(GDIM, BIDX);
    fg::Gemm g{p->ya, p->Wt_br + (size_t)l * 3 * 1024 * 512, 512, nullptr};
    fg::EpiZ E{zbuf(p, 0), zbuf(p, 2)};
    __syncthreads();
    fg::gemm_phase((LAS unsigned char*)(smem), g, S, E);
  }
  if (l == DEPTH - 1) return;
  u16* sm = reinterpret_cast<u16*>(smem);
  const int lane = TIDX & 63, wid = TIDX >> 6, c = lane & 31, hh = lane >> 5, wm = wid >> 2, wn = wid & 3;
  for (int u = (BIDX + 64) % GDIM; u < 192; u += GDIM) {
    const int br = u >> 6, mt = (u >> 3) & 7, nt = u & 7;
    f32x16 acc[1][1]; zero_acc(acc);
    XRowLin xr{p->ya + ((size_t)br * TT + TL + mt * 64) * 512, (size_t)512};
    __syncthreads();
    GemmS::kloop(acc, xr, p->Wt_br + ((size_t)(l * 3 + br) * 1024 + nt * 128) * 512, 512, 512, sm);
    u16* dst = (br < 2 ? zbuf(p, 0) + (size_t)br * TT * DM : zbuf(p, 2)) + (size_t)(TL + mt * 64 + wm * 32 + c) * DM + nt * 128 + wn * 32;
#pragma unroll
    for (int g = 0; g < 4; ++g) st_bf4(dst + 8 * g + 4 * hh, acc[0][0][4 * g], acc[0][0][4 * g + 1], acc[0][0][4 * g + 2], acc[0][0][4 * g + 3]);
  }
}

DEVI void phase_merge2(PP p, int l) {
  const int lane = TIDX & 63, gw = BIDX * 8 + (TIDX >> 6), nw = GDIM * 8;
  const int nrows = (l == DEPTH - 1) ? TL : TT;
  const u16* z0 = zbuf(p, 0); const u16* z1 = zbuf(p, 1); const u16* z2 = zbuf(p, 2);
  for (int r = gw; r < nrows; r += nw) {
#pragma unroll
    for (int i = 0; i < 4; ++i) {
      const int col = i * 256 + lane * 4;
      const size_t zo = (size_t)r * DM + col;
      const u16* lg = p->P + (size_t)r * NINP + O_LOG + col;
      const u32x2 a0 = *reinterpret_cast<const u32x2*>(z0 + zo), a1 = *reinterpret_cast<const u32x2*>(z1 + zo), a2 = *reinterpret_cast<const u32x2*>(z2 + zo);
      const u32x2 g0 = *reinterpret_cast<const u32x2*>(lg), g1 = *reinterpret_cast<const u32x2*>(lg + 1024), g2 = *reinterpret_cast<const u32x2*>(lg + 2048);
      u32x2 o;
#pragma unroll
      for (int j = 0; j < 2; ++j) {
        const float lo = sigmoidf_(bflo(g0[j])) * bflo(a0[j]) + sigmoidf_(bflo(g1[j])) * bflo(a1[j]) + sigmoidf_(bflo(g2[j])) * bflo(a2[j]);
        const float hi = sigmoidf_(bfhi(g0[j])) * bfhi(a0[j]) + sigmoidf_(bfhi(g1[j])) * bfhi(a1[j]) + sigmoidf_(bfhi(g2[j])) * bfhi(a2[j]);
        o[j] = cvtpk(lo, hi);
      }
      *reinterpret_cast<u32x2*>(p->hb + zo) = o;
    }
  }
}

DEVI void phase_wout(PP p, int l, char* smem) {
  {
    fg::StaticOrder S; S.init(TL / 256, DM / 256, GDIM, BIDX);
    fg::Gemm g{p->hb, p->Wt_out + (size_t)l * DM * DM, DM, nullptr};
    fg::EpiWout E{l == 0 ? p->x : p->xw, p->xw, modp(p, l, 0, 2), modp(p, l, 1, 2)};
    __syncthreads();
    fg::gemm_phase((LAS unsigned char*)(smem), g, S, E);
  }
  if (l == DEPTH - 1) return;
  u16* sm = reinterpret_cast<u16*>(smem);
  const int lane = TIDX & 63, wid = TIDX >> 6, c = lane & 31, hh = lane >> 5, wm = wid >> 2, wn = wid & 3;
  for (int u = (BIDX + 128) % GDIM; u < 64; u += GDIM) {
    const int r0 = TL + (u >> 3) * 64, nt = u & 7;
    f32x16 acc[1][1]; zero_acc(acc);
    XRowLin xr{p->hb + (size_t)r0 * DM, (size_t)DM};
    __syncthreads();
    GemmS::kloop(acc, xr, p->Wt_out + (size_t)l * DM * DM + (size_t)nt * 128 * DM, DM, DM, sm);
    const int row = r0 + wm * 32 + c;
    const float* g1 = modp(p, l, 2, 2);
    const float* xo = xin_row(p, l, row);
    f32x4 gv4[4], xv4[4];
#pragma unroll
    for (int g = 0; g < 4; ++g) { const int feat = nt * 128 + wn * 32 + 8 * g + 4 * hh; gv4[g] = *reinterpret_cast<const f32x4*>(g1 + feat); xv4[g] = *reinterpret_cast<const f32x4*>(xo + feat); }
#pragma unroll
    for (int g = 0; g < 4; ++g) { const int feat = nt * 128 + wn * 32 + 8 * g + 4 * hh;
      const f32x4 gv = gv4[g], xv = xv4[g];
      const f32x4 o = {xv[0] + gv[0] * acc[0][0][4 * g], xv[1] + gv[1] * acc[0][0][4 * g + 1], xv[2] + gv[2] * acc[0][0][4 * g + 2], xv[3] + gv[3] * acc[0][0][4 * g + 3]};
      *reinterpret_cast<f32x4*>(p->xw + (size_t)row * DM + feat) = o; }
  }
}

DEVI void phase_norm2(PP p, int l, char* smem) {
  float* rs = reinterpret_cast<float*>(smem);
  const int tid = TIDX, lane = tid & 63, gw = BIDX * 8 + (tid >> 6), nw = GDIM * 8;
  __syncthreads();
  {
    f32x4 rw[8];
#pragma unroll
    for (int q = 0; q < 8; ++q) rw[q] = *reinterpret_cast<const f32x4*>(p->router_w + (size_t)l * DM * NE + (size_t)(q * NTHR + tid) * 4);
#pragma unroll
    for (int q = 0; q < 8; ++q) { const int i = (q * NTHR + tid) * 4; float* d = rs + (i >> 4) * 17 + (i & 15); d[0] = rw[q][0]; d[1] = rw[q][1]; d[2] = rw[q][2]; d[3] = rw[q][3]; }
  }
  __syncthreads();
  const int nrows = (l == DEPTH - 1) ? TL : TT;
  for (int r = gw; r < nrows; r += nw) {
    const int cond = row_cond(r);
    const float* xr = p->xw + (size_t)r * DM;
    float v[16]; float ss = 0.f;
#pragma unroll
    for (int i = 0; i < 16; ++i) { v[i] = xr[lane + 64 * i]; ss += v[i] * v[i]; }
    ss = wave_sum(ss);
    const float rstd = rsqrtf(ss * (1.f / DM) + EPS);
    const float* nw_ = p->norm2_w + l * DM; const float* sc = modp(p, l, cond, 4); const float* sh = modp(p, l, cond, 3);
    f32x2 lg2[8];
#pragma unroll
    for (int e = 0; e < 8; ++e) lg2[e] = (f32x2){0.f, 0.f};
#pragma unroll
    for (int i = 0; i < 16; ++i) {
      const int k = lane + 64 * i;
      const float h = v[i] * rstd * nw_[k] * (1.f + sc[k]) + sh[k];
      p->hb[(size_t)r * DM + k] = f2bf(h);
      const f32x2 h2 = {h, h};
#pragma unroll
      for (int e = 0; e < 8; ++e) lg2[e] += h2 * (f32x2){rs[k * 17 + 2 * e], rs[k * 17 + 2 * e + 1]};
    }
    float lg[16];
#pragma unroll
    for (int e = 0; e < 8; ++e) { lg[2 * e] = lg2[e][0]; lg[2 * e + 1] = lg2[e][1]; }
    float mx = -1e30f;
#pragma unroll
    for (int e = 0; e < 16; ++e) { lg[e] = wave_sum(lg[e]); mx = fmaxf(mx, lg[e]); }
    float sum = 0.f;
#pragma unroll
    for (int e = 0; e < 16; ++e) { lg[e] = __expf(lg[e] - mx); sum += lg[e]; }
    const float inv = 1.f / sum;
    float mine = 0.f;
#pragma unroll
    for (int e = 0; e < 16; ++e) mine = (lane == e) ? lg[e] * inv : mine;
    if (lane < 16) {
      if (r < TL) p->aff[((size_t)(r >> 13) * NE + lane) * SEQ + (r & (SEQ - 1))] = mine;
      else { const int rc = r - TL; p->aff[(size_t)NB * NE * SEQ + ((size_t)(rc >> 8) * NE + lane) * CTXL + (rc & (CTXL - 1))] = mine; }
    }
  }
}

DEVI void topk_problem(PP p, int l, int prob, char* smem) {
  unsigned* vals = reinterpret_cast<unsigned*>(smem);
  unsigned* hist = vals + 8192;
  unsigned* sc = hist + 256;
  const int tid = TIDX, lane = tid & 63, wid = tid >> 6;
  const bool lat = prob < 32; const int pb = lat ? prob : prob - 32, b = pb >> 4, e = pb & 15;
  const int n = lat ? SEQ : CTXL, k = lat ? 1024 : 32;
  const float* src = p->aff + (lat ? ((size_t)b * NE + e) * SEQ : (size_t)NB * NE * SEQ + ((size_t)b * NE + e) * CTXL);
  const int sbase = lat ? b * 1024 : 2048 + b * 32, rowbase = lat ? b * SEQ : TL + b * CTXL;
  __syncthreads();
  if (lat) {
    u32x4 tv[4];
#pragma unroll
    for (int q = 0; q < 4; ++q) tv[q] = *reinterpret_cast<const u32x4*>(src + (size_t)(q * NTHR + tid) * 4);
#pragma unroll
    for (int q = 0; q < 4; ++q) *reinterpret_cast<u32x4*>(vals + (q * NTHR + tid) * 4) = tv[q];
  } else {
    for (int i = tid; i < n; i += NTHR) vals[i] = __float_as_uint(src[i]);
  }
  unsigned prefix = 0, mask = 0, kk = (unsigned)k;
  for (int pass = 3; pass >= 0; --pass) {
    const int shift = pass * 8;
    if (tid < 256) hist[tid] = 0;
    __syncthreads();
    for (int i = tid; i < n; i += NTHR) { const unsigned v = vals[i]; if ((v & mask) == prefix) atomicAdd(&hist[(v >> shift) & 255u], 1u); }
    __syncthreads();
    if (wid == 0) {
      const int b0 = 255 - 4 * lane;
      const unsigned h0 = hist[b0], h1 = hist[b0 - 1], h2 = hist[b0 - 2], h3 = hist[b0 - 3];
      unsigned incl = h0 + h1 + h2 + h3;
#pragma unroll
      for (int o = 1; o < 64; o <<= 1) { const unsigned t = shfl_up_u(incl, o, lane); if (lane >= o) incl += t; }
      const unsigned excl = incl - (h0 + h1 + h2 + h3);
      if (excl < kk && incl >= kk) {
        unsigned cum = excl; int d = b0;
        if (cum + h0 < kk) { cum += h0; d = b0 - 1; if (cum + h1 < kk) { cum += h1; d = b0 - 2; if (cum + h2 < kk) { cum += h2; d = b0 - 3; } } }
        sc[0] = prefix | ((unsigned)d << shift); sc[1] = kk - cum;
      }
    }
    __syncthreads();
    prefix = sc[0]; kk = sc[1]; mask |= 0xffu << shift;
    __syncthreads();
  }
  const unsigned thr = prefix, need_eq = kk;
  const int per = lat ? 16 : 1, i0 = tid * per;
  unsigned cnt = 0;
  if (i0 < n) for (int j = 0; j < per; ++j) { const unsigned v = vals[i0 + j]; cnt += (v > thr ? 1u : 0u) + (v == thr ? 65536u : 0u); }
  unsigned incl = cnt;
#pragma unroll
  for (int o = 1; o < 64; o <<= 1) { const unsigned t = shfl_up_u(incl, o, lane); if (lane >= o) incl += t; }
  if (lane == 63) sc[8 + wid] = incl;
  __syncthreads();
  unsigned woff = 0;
  for (int w = 0; w < wid; ++w) woff += sc[8 + w];
  unsigned run = woff + incl - cnt;
  if (i0 < n) for (int j = 0; j < per; ++j) {
    const int i = i0 + j; const unsigned v = vals[i];
    const unsigned gtb = run & 0xffffu, eqb = run >> 16;
    const bool isgt = v > thr, iseq = v == thr, selq = isgt || (iseq && eqb < need_eq);
    const int slot = sbase + (int)(gtb + (eqb < need_eq ? eqb : need_eq));
    const int row = rowbase + i;
    if (selq) { p->ridx[e * ESLOTS + slot] = row; p->rgate[e * ESLOTS + slot] = __uint_as_float(v); }
    p->sel[(size_t)row * 16 + e] = selq ? slot : -1;
    run += (isgt ? 1u : 0u) + (iseq ? 65536u : 0u);
  }
  if (lat && b == 0) { const int lo = (l == DEPTH - 1) ? 2048 : 2112; for (int s = lo + tid; s < ESLOTS; s += NTHR) { p->ridx[e * ESLOTS + s] = 0; p->rgate[e * ESLOTS + s] = 0.f; } }
}

DEVI void phase_gather(PP p) {
  const int lane = TIDX & 63, gw = BIDX * 8 + (TIDX >> 6), nw = GDIM * 8;
  for (int r = gw; r < NE * 2048; r += nw) {
    const int e = r >> 11, slot = r & 2047;
    const u16* src = p->hb + (size_t)p->ridx[e * ESLOTS + slot] * DM;
    u16* dst = p->Xg + ((size_t)e * ESLOTS + slot) * DM;
    const u32x4 a = *reinterpret_cast<const u32x4*>(src + lane * 8), b2 = *reinterpret_cast<const u32x4*>(src + 512 + lane * 8);
    *reinterpret_cast<u32x4*>(dst + lane * 8) = a; *reinterpret_cast<u32x4*>(dst + 512 + lane * 8) = b2;
  }
}
DEVI void phase_exp1(PP p, int l, char* smem) {
  {
    fg::ExpertOrder S; S.init(8, 8, ESLOTS / 256, GDIM, BIDX);
    fg::Gemm g{p->hb, p->We13 + (size_t)l * NE * 2048 * DM, DM, p->ridx};
    fg::EpiSwiglu E{p->hid};
    __syncthreads();
    fg::gemm_phase<fg::EpiSwiglu, fg::ExpertOrder, true>((LAS unsigned char*)(smem), g, S, E);
  }
  if (l == DEPTH - 1) return;
  u16* sm = reinterpret_cast<u16*>(smem);
  const int lane = TIDX & 63, wid = TIDX >> 6, c = lane & 31, hh = lane >> 5, wm = wid >> 2, wn = wid & 3;
  for (int u = BIDX; u < NE * 8; u += GDIM) {
    const int e = u >> 3, jf = u & 7;
    f32x16 a1[1][1], a3[1][1]; zero_acc(a1); zero_acc(a3);
    XRowIdx xr{p->hb, p->ridx + e * ESLOTS + 2048};
    const u16* wb = p->We13 + ((size_t)(l * NE + e) * 2048 + jf * 256) * DM;
    __syncthreads();
    GemmS::kloop(a1, xr, wb, DM, DM, sm);
    GemmS::kloop(a3, xr, wb + (size_t)128 * DM, DM, DM, sm);
    const int slot = 2048 + wm * 32 + c;
    u16* dst = p->hid + ((size_t)e * ESLOTS + slot) * FF + jf * 128 + wn * 32;
#pragma unroll
    for (int g = 0; g < 4; ++g) {
      float o[4];
#pragma unroll
      for (int j = 0; j < 4; ++j) o[j] = siluf_(a1[0][0][4 * g + j]) * a3[0][0][4 * g + j];
      st_bf4(dst + 8 * g + 4 * hh, o[0], o[1], o[2], o[3]);
    }
  }
}
DEVI void phase_exp2(PP p, int l, char* smem) {
  {
    fg::ExpertOrder S; S.init(8, 4, ESLOTS / 256, GDIM, BIDX);
    fg::Gemm g{p->hid, p->We2 + (size_t)l * NE * DM * FF, FF, nullptr};
    fg::EpiY E{p->Y, p->rgate};
    __syncthreads();
    fg::gemm_phase((LAS unsigned char*)(smem), g, S, E);
  }
  if (l == DEPTH - 1) return;
  u16* sm = reinterpret_cast<u16*>(smem);
  const int lane = TIDX & 63, wid = TIDX >> 6, c = lane & 31, hh = lane >> 5, wm = wid >> 2, wn = wid & 3;
  for (int u = BIDX; u < NE * 8; u += GDIM) {
    const int e = u >> 3, nt = u & 7;
    f32x16 acc[1][1]; zero_acc(acc);
    XRowLin xr{p->hid + ((size_t)e * ESLOTS + 2048) * FF, (size_t)FF};
    __syncthreads();
    GemmS::kloop(acc, xr, p->We2 + ((size_t)(l * NE + e) * DM + nt * 128) * FF, FF, FF, sm);
    const int slot = 2048 + wm * 32 + c;
    const float gt = p->rgate[e * ESLOTS + slot];
    u16* dst = p->Y + ((size_t)e * ESLOTS + slot) * DM + nt * 128 + wn * 32;
#pragma unroll
    for (int g = 0; g < 4; ++g) st_bf4(dst + 8 * g + 4 * hh, gt * acc[0][0][4 * g], gt * acc[0][0][4 * g + 1], gt * acc[0][0][4 * g + 2], gt * acc[0][0][4 * g + 3]);
  }
}

DEVI void phase_proj_scan_a(PP p, int l, char* smem, unsigned* ctr) {
  u16* sm = reinterpret_cast<u16*>(smem);
  int* slot = reinterpret_cast<int*>(smem + LDS_BYTES - 128);
  constexpr int NQ = (TT / 256) * 8, NQ2 = NQ / 2, NSC = NB * 8 * NCHUNK;
  const int total = NQ + NQ2 + NSC;
  int nxt = (TIDX == 0) ? (int)atomicAdd(ctr, 1u) : 0;
  for (;;) {
    __syncthreads();
    if (TIDX == 0) *slot = nxt;
    __syncthreads();
    const int u = *slot;
    if (u >= total) break;
    if (TIDX == 0) nxt = (int)atomicAdd(ctr, 1u);
    if (u < NQ) mlakv_unit(p, l, u >> 3, u & 7, sm);
    else if (u < NQ + NQ2) mlaq_unit2(p, l, (u - NQ) >> 2, (u - NQ) & 3, sm);
    else {
      const int v = u - NQ - NQ2;
      const int bh = v / NCHUNK, cc = v % NCHUNK, seg = cc < 2 ? 1 : 0, ck = seg ? cc : cc - 2;
      scan_a_pair(p, l, bh >> 3, bh & 7, seg, ck, smem);
    }
  }
}
DEVI void scan_c_item(PP p, int l, int it, char* smem, ScanCPre& pre, int nxt_ticket, int& nit) {
  bool ml; int b, head, seg, ck; scan_c_decode(l, it, ml, b, head, seg, ck);
  if (ml) scan_c_unit<true>(p, l, b, head, seg, ck, smem, pre, nxt_ticket, nit); else scan_c_unit<false>(p, l, b, head, seg, ck, smem, pre, nxt_ticket, nit);
}
DEVI void phase_attn_carry(PP p, int l, char* smem, unsigned* ctr) {
  u16* sm = reinterpret_cast<u16*>(smem);
  int* slot = reinterpret_cast<int*>(smem + LDS_BYTES - 128);
  const bool lastl = (l == DEPTH - 1);
  const bool fast = __builtin_amdgcn_readfirstlane(__float_as_int(p->attb[l])) < __float_as_int(60.f);
  const int x0 = (int)(xb_xcc_id() & 7u);
  for (int sx = 0; sx < 8; ++sx) {
    const int x = (x0 + sx) & 7;
    const int natt = lastl ? 64 : 66;
    const int total = 4 + natt;
    int nxt = (TIDX == 0) ? (int)atomicAdd(ctr + x * 8, 1u) : 0;
    for (;;) {
      __syncthreads();
      if (TIDX == 0) *slot = nxt;
      __syncthreads();
      const int u = *slot;
      if (u >= total) break;
      if (TIDX == 0) nxt = (int)atomicAdd(ctr + x * 8, 1u);
      if (u < 4) {
        carry_pair(p, u * 8 + x);
        asm volatile("s_waitcnt vmcnt(0)" ::: "memory");
        __syncthreads();
        if (TIDX == 0) { __builtin_amdgcn_fence(__ATOMIC_RELEASE, "agent"); asm volatile("s_waitcnt vmcnt(0)" ::: "memory");
          __hip_atomic_fetch_add(ctr + 4, 1u, __ATOMIC_RELAXED, __HIP_MEMORY_SCOPE_AGENT); }
        continue;
      }
      const int att = u - 4;
      {
        int bh, q0, nk;
        if (att < 64) { bh = (att < 32) ? x : x + 8; q0 = (bh >> 3) * SEQ + (att & 31) * 256; nk = KEYS; }
        else { bh = (att == 64) ? x : x + 8; q0 = TL + (bh >> 3) * CTXL; nk = CTXL; }
        if (fast) attn_unit<true>(p, bh >> 3, bh & 7, q0, nk, sm); else attn_unit<false>(p, bh >> 3, bh & 7, q0, nk, sm);
      }
    }
  }
  __syncthreads();
  if (TIDX == 0) {
    unsigned sp = 0;
    while (__hip_atomic_load(ctr + 4, __ATOMIC_RELAXED, __HIP_MEMORY_SCOPE_AGENT) < 32u) { __builtin_amdgcn_s_sleep(2); if (++sp > (1u << 22)) break; }
    __builtin_amdgcn_fence(__ATOMIC_ACQUIRE, "agent");
    asm volatile("s_waitcnt vmcnt(0)" ::: "memory");
  }
  __syncthreads();
  {
    const int nsc = 2 * NB * 8 * (lastl ? 64 : NCHUNK);
    const int total = lastl ? nsc : ((nsc + 8) / 9) * 11;
    int nxt = (TIDX == 0) ? (int)atomicAdd(ctr + 5, 1u) : 0;
    ScanCPre pre; int pre_it = -1;
    for (;;) {
      __syncthreads();
      if (TIDX == 0) *slot = nxt;
      __syncthreads();
      const int u = *slot;
      if (u >= total) break;
      if (TIDX == 0) nxt = (int)atomicAdd(ctr + 5, 1u);
      const int it = scan_ticket_item(l, u);
      if (it >= 0) {
        if (pre_it != it) scan_c_preload(p, l, it, pre);
        int nit = -1;
        scan_c_item(p, l, it, smem, pre, nxt, nit);
        pre_it = nit;
        continue;
      }
      pre_it = -1;
      if (lastl) continue;
      const int g = u / 11, r = u - g * 11;
      if (r < 9) { }
      else {
        const int j = g * 2 + (r - 9);
        if (j < CVT_JOBS) cvt_bundle(p, l + 1, j, CT_LAYER - cvt_fill_tiles());
      }
    }
  }
}

DEVI void phase_topk(PP p, int l, char* smem) {
  const int nprob = (l == DEPTH - 1) ? 32 : 64;
  for (int u = BIDX; u < nprob; u += GDIM) topk_problem(p, l, u, smem);
}

constexpr int STEPS_PER_LAYER = 11, NSTEPS = 1 + DEPTH * STEPS_PER_LAYER + 1;
__global__ void __launch_bounds__(NTHR, 2) mega(Params p_by_value, int s_lo, int s_hi) {
  extern __shared__ __attribute__((aligned(16))) char lds[];
  PP p = (PP)__builtin_amdgcn_kernarg_segment_ptr();
  if (TIDX == 0) { reinterpret_cast<unsigned*>(lds)[0] = 0u; reinterpret_cast<unsigned*>(lds)[1] = 0u; reinterpret_cast<unsigned*>(lds)[2] = 0u; reinterpret_cast<unsigned*>(lds)[3] = 0u; }
  __syncthreads();
  XcdBarrier bar = xcd_barrier_post(p->bar + (size_t)s_lo * XCD_BAR_WORDS, (volatile LAS unsigned*)lds);
  char* smem = lds + 64;
  int s = 0;
#define STEP(...) do { if (s >= s_lo && s < s_hi) { asm volatile("" : "+s"(p)); __VA_ARGS__; if (s + 1 < s_hi) xcd_barrier(bar); } ++s; } while (0)
#ifndef PROBE_MASK
#define PROBE_MASK 0
#endif
#define DUP(bit, ...) do { __VA_ARGS__; if (PROBE_MASK & (1 << (bit))) { __syncthreads(); __VA_ARGS__; } } while (0)
  STEP(DUP(0, phase_prologue(p, smem)));
#pragma unroll 1
  for (int l = 0; l < DEPTH; ++l) {
    STEP({ if (l == 0) phase_norm1<false, false>(p, l); else phase_norm1<true, false>(p, l); });
    STEP(DUP(1, phase_inproj(p, l, smem)));
    STEP(phase_proj_scan_a(p, l, smem, p->ctr + 64 * l + 6));
    STEP(phase_attn_carry(p, l, smem, p->ctr + 64 * l));
    STEP(phase_merge(p, l, smem));
    STEP(phase_merge2(p, l));
    STEP(phase_wout(p, l, smem));
    STEP(DUP(6, phase_norm2(p, l, smem)));
    STEP(DUP(7, phase_topk(p, l, smem)));
    STEP(DUP(8, phase_exp1(p, l, smem)));
    STEP(DUP(9, phase_exp2(p, l, smem)));
  }
  STEP((phase_norm1<true, true>(p, DEPTH)));
#undef STEP
}

#ifndef MK_MULTI
#define MK_MULTI 0
#endif
extern "C" void kernel_launch(void* const* d_in, const int* in_sizes, int n_in, void* d_out, int out_size, void* d_ws, size_t ws_size, hipStream_t stream) {
  static int grid = 0;
  if (grid == 0) {
    int dev = 0, cus = 0, per_cu = 0;
    (void)hipGetDevice(&dev); (void)hipDeviceGetAttribute(&cus, hipDeviceAttributeMultiprocessorCount, dev);
    (void)hipFuncSetAttribute((const void*)mega, hipFuncAttributeMaxDynamicSharedMemorySize, LDS_BYTES);
    (void)hipOccupancyMaxActiveBlocksPerMultiprocessor(&per_cu, (const void*)mega, NTHR, LDS_BYTES);
    (void)hipGetLastError();
    grid = cus > 0 ? cus : 256;
    if (per_cu < 1) fprintf(stderr, "kernel_launch: occupancy query reports %d blocks per CU\n", per_cu);
  }
  Params p{};
  const float** in = reinterpret_cast<const float**>(&p);
  for (int i = 0; i < 26; ++i) in[i] = (const float*)d_in[i];
  p.out = (float*)d_out;
  char* w = (char*)d_ws; size_t off = 0;
  auto take = [&](size_t bytes) { char* r = w + off; off += (bytes + 255) & ~(size_t)255; return r; };
  const size_t ctl_bytes = (size_t)(NSTEPS + 1) * XCD_BAR_WORDS * 4 + 4096;
  p.bar = (unsigned*)take(ctl_bytes); p.ctr = p.bar + (size_t)(NSTEPS + 1) * XCD_BAR_WORDS;
  p.Wt_in = (u16*)take((size_t)DEPTH * NINP * DM * 2 + 65536);
  p.Wt_qb = (u16*)take((size_t)DEPTH * 768 * 384 * 2);
  p.Wt_kvb = (u16*)take((size_t)DEPTH * 1024 * 256 * 2);
  p.Wt_br = (u16*)take((size_t)DEPTH * 3 * 1024 * 512 * 2);
  p.Wt_out = (u16*)take((size_t)DEPTH * DM * DM * 2);
  p.We13 = (u16*)take((size_t)DEPTH * NE * 2048 * DM * 2);
  p.We2 = (u16*)take((size_t)DEPTH * NE * DM * FF * 2);
  p.mod = (float*)take((size_t)DEPTH * 3 * 6144 * 4);
  p.rope = (float*)take(128 * 16 * 4); p.attb = (float*)take(256);
  p.xw = (float*)take((size_t)TT * DM * 4);
  p.gates = (float*)take((size_t)TT * 32 * 4);
  p.hb = (u16*)take((size_t)TT * DM * 2);
  p.P = (u16*)take((size_t)TT * NINP * 2);
  p.Q = (u16*)take((size_t)TT * 768 * 2);
  p.K = (u16*)take((size_t)NB * KEYS * 768 * 2);
  p.Vt = (u16*)take((size_t)NB * 8 * 64 * KEYS * 2);
  p.ya = (u16*)take((size_t)TT * 512 * 2); p.yb = (u16*)take((size_t)TT * 512 * 2); p.yc = (u16*)take((size_t)TT * 512 * 2);
  p.dC = (float*)take((size_t)32 * NCHUNK * 4096 * 4); p.dN = (float*)take((size_t)32 * NCHUNK * 64 * 4); p.dM = (float*)take((size_t)32 * NCHUNK * 2 * 4);
  p.nin = (float*)take((size_t)32 * NCHUNK * 64 * 4); p.min_ = (float*)take((size_t)32 * NCHUNK * 4); p.dR = (float*)take((size_t)32 * NCHUNK * 2048 * 4);
  p.Cin = (u16*)take((size_t)32 * NCHUNK * 4096 * 2); p.Rin = (u16*)take((size_t)32 * NCHUNK * 2048 * 2);
  p.aff = (float*)take((size_t)TT * NE * 4); p.rgate = (float*)take((size_t)NE * ESLOTS * 4);
  p.ridx = (int*)take((size_t)NE * ESLOTS * 4); p.sel = (int*)take((size_t)TT * NE * 4);
  p.gq = (float*)take((size_t)32 * NCHUNK * 512 * 4);
  p.Kc = (u16*)take((size_t)TT * 512 * 2);
  p.hid = p.P; p.Y = p.P + (size_t)NE * ESLOTS * FF; p.Xg = p.Y + (size_t)NE * ESLOTS * DM;
  if (off > ws_size || n_in != 26 || out_size != TL * DM) { fprintf(stderr, "kernel_launch: workspace %zu needed, %zu given (n_in %d out %d)\n", off, ws_size, n_in, out_size); return; }
  (void)hipMemsetAsync(p.bar, 0, ctl_bytes, stream);
#if MK_MULTI
  for (int s = 0; s < NSTEPS; ++s) hipLaunchKernelGGL(mega, dim3(grid), dim3(NTHR), LDS_BYTES, stream, p, s, s + 1);
#else
  hipLaunchKernelGGL(mega, dim3(grid), dim3(NTHR), LDS_BYTES, stream, p, 0, NSTEPS);
#endif
}
```
